# Optimizing an MI355X kernel written in HIP

```python
import math
import jax, jax.numpy as jnp
from jax import lax
import numpy as np

D_MODEL = 2048
BATCH = 4
SEQ = 4096
DEPTH = 4

MEM_LEN = 256
FOX_HEAD_DIM = 128
FOX_HEADS = (3 * D_MODEL // 8) // FOX_HEAD_DIM
FOX_W = FOX_HEADS * FOX_HEAD_DIM
DIFF_QK_DIM = 64
DIFF_V_DIM = 2 * DIFF_QK_DIM
DIFF_HEADS = (3 * D_MODEL // 8) // DIFF_V_DIM
DIFF_QK_W = DIFF_HEADS * 2 * DIFF_QK_DIM
DIFF_V_W = DIFF_HEADS * DIFF_V_DIM
CONV_CH = D_MODEL - FOX_W - DIFF_V_W
CONV_WIDTH = 3
MIX_WIDTH = FOX_W + DIFF_V_W + CONV_CH
IN_SIZES = (FOX_W, FOX_W, FOX_W, FOX_HEADS,
            DIFF_QK_W, DIFF_QK_W, DIFF_V_W,
            CONV_CH, CONV_CH, CONV_CH)
IN_WIDTH = sum(IN_SIZES)
IN_SPLITS = [int(v) for v in np.cumsum(IN_SIZES)[:-1]]
ROPE_THETA = 500000.0
ROT_DIM = DIFF_QK_DIM // 4
CROSS_HEADS = 4
CROSS_HEAD_DIM = 128
CROSS_W = CROSS_HEADS * CROSS_HEAD_DIM
D_FF = 5632
Q_BLOCK = 128
EPS = 1e-6
NEG_INF = -1e30

kernel_name = "hymba_fox_diff_conv_macaron"


def rmsnorm(x, g):
    x32 = x.astype(jnp.float32)
    y = x32 * lax.rsqrt(jnp.mean(x32 * x32, axis=-1, keepdims=True) + EPS)
    return (y * g.astype(jnp.float32)).astype(x.dtype)


def swiglu(x, w_gate, w_up, w_down):
    return (jax.nn.silu(x @ w_gate) * (x @ w_up)) @ w_down


def partial_rope(x, cos, sin):
    half = ROT_DIM // 2
    xr = x[..., :ROT_DIM].astype(jnp.float32)
    x1, x2 = xr[..., :half], xr[..., half:]
    rot = jnp.concatenate([x1 * cos - x2 * sin, x2 * cos + x1 * sin], axis=-1).astype(x.dtype)
    return jnp.concatenate([rot, x[..., ROT_DIM:]], axis=-1)


def fox_attention(q, k, v, log_f):
    B, S, H, Dh = q.shape
    nb = S // Q_BLOCK
    c = jnp.cumsum(log_f, axis=1)
    c_keys = c.transpose(0, 2, 1)
    q_blocks = q.reshape(B, nb, Q_BLOCK, H, Dh).swapaxes(0, 1)
    c_blocks = c.reshape(B, nb, Q_BLOCK, H).swapaxes(0, 1)
    key_pos = jnp.arange(S)
    scale = Dh ** -0.5

    def block(args):
        qi, ci, i = args
        s = jnp.einsum('bqhd,bkhd->bhqk', qi, k).astype(jnp.float32) * scale
        s = s + ci.transpose(0, 2, 1)[..., None] - c_keys[:, :, None, :]
        mask = (i * Q_BLOCK + jnp.arange(Q_BLOCK))[:, None] >= key_pos[None, :]
        p = jax.nn.softmax(jnp.where(mask, s, NEG_INF), axis=-1)
        return jnp.einsum('bhqk,bkhd->bqhd', p.astype(v.dtype), v)

    out = lax.map(block, (q_blocks, c_blocks, jnp.arange(nb)))
    return out.swapaxes(0, 1).reshape(B, S, H, Dh)


def diff_attention(q, k, v, lam):
    B, S, H, _, dk = q.shape
    nb = S // Q_BLOCK
    q_blocks = q.reshape(B, nb, Q_BLOCK, H, 2, dk).swapaxes(0, 1)
    key_pos = jnp.arange(S)
    scale = dk ** -0.5

    def block(args):
        qi, i = args
        s = jnp.einsum('bqhcd,bkhcd->bhcqk', qi, k).astype(jnp.float32) * scale
        mask = (i * Q_BLOCK + jnp.arange(Q_BLOCK))[:, None] >= key_pos[None, :]
        p = jax.nn.softmax(jnp.where(mask, s, NEG_INF), axis=-1)
        a = p[:, :, 0] - lam * p[:, :, 1]
        return jnp.einsum('bhqk,bkhd->bqhd', a.astype(v.dtype), v)

    out = lax.map(block, (q_blocks, jnp.arange(nb)))
    return out.swapaxes(0, 1).reshape(B, S, H, v.shape[-1])


def causal_depthwise_conv(z, w, b):
    S = z.shape[1]
    zp = jnp.pad(z, ((0, 0), (CONV_WIDTH - 1, 0), (0, 0)))
    out = zp[:, 0:S] * w[0]
    for j in range(1, CONV_WIDTH):
        out = out + zp[:, j:j + S] * w[j]
    return out + b


def cross_attention(xn, memn, w_q, w_kv, w_o):
    B, S, _ = xn.shape
    M = memn.shape[1]
    q = (xn @ w_q).reshape(B, S, CROSS_HEADS, CROSS_HEAD_DIM)
    kv = (memn @ w_kv).reshape(B, M, 2, CROSS_HEADS, CROSS_HEAD_DIM)
    k, v = kv[:, :, 0], kv[:, :, 1]
    s = jnp.einsum('bqhd,bmhd->bhqm', q, k).astype(jnp.float32) * (CROSS_HEAD_DIM ** -0.5)
    p = jax.nn.softmax(s, axis=-1)
    o = jnp.einsum('bhqm,bmhd->bqhd', p.astype(v.dtype), v).reshape(B, S, CROSS_W)
    return o @ w_o


def setup_inputs(seed: int = 0) -> dict:
    key = jax.random.key(seed)
    ks = jax.random.split(key, 32)

    def w(k, shape, fan_in):
        return jax.random.normal(k, shape, jnp.float32) * (fan_in ** -0.5)

    def gain(k, shape):
        return 1.0 + 0.02 * jax.random.normal(k, shape, jnp.float32)

    L, D = DEPTH, D_MODEL
    x = jax.random.normal(ks[0], (BATCH, SEQ, D), jnp.float32)
    mem = jax.random.normal(ks[1], (BATCH, MEM_LEN, D), jnp.float32)
    offsets = jax.random.randint(ks[2], (BATCH, 1), 0, 1024, dtype=jnp.int32)
    positions = (offsets + jnp.arange(SEQ, dtype=jnp.int32)[None, :]).astype(jnp.int32)
    return {
        "x": x,
        "mem": mem,
        "positions": positions,
        "ffn1_norm": gain(ks[3], (L, D)),
        "ffn1_w_gate": w(ks[4], (L, D, D_FF), D),
        "ffn1_w_up": w(ks[5], (L, D, D_FF), D),
        "ffn1_w_down": w(ks[6], (L, D_FF, D), D_FF),
        "mix_norm": gain(ks[7], (L, D)),
        "mix_w_in": w(ks[8], (L, D, IN_WIDTH), D),
        "forget_bias": jax.random.uniform(ks[9], (L, FOX_HEADS), jnp.float32, 1.0, 4.0),
        "conv_w": w(ks[10], (L, CONV_WIDTH, CONV_CH), CONV_WIDTH),
        "conv_b": 0.01 * jax.random.normal(ks[11], (L, CONV_CH), jnp.float32),
        "lambda_q1": 0.1 * jax.random.normal(ks[12], (L, DIFF_QK_DIM), jnp.float32),
        "lambda_k1": 0.1 * jax.random.normal(ks[13], (L, DIFF_QK_DIM), jnp.float32),
        "lambda_q2": 0.1 * jax.random.normal(ks[14], (L, DIFF_QK_DIM), jnp.float32),
        "lambda_k2": 0.1 * jax.random.normal(ks[15], (L, DIFF_QK_DIM), jnp.float32),
        "diff_subln": gain(ks[16], (L, DIFF_V_DIM)),
        "mix_w_out": w(ks[17], (L, MIX_WIDTH, D), MIX_WIDTH),
        "cross_norm": gain(ks[18], (L, D)),
        "mem_norm": gain(ks[19], (L, D)),
        "cross_w_q": w(ks[20], (L, D, CROSS_W), D),
        "cross_w_kv": w(ks[21], (L, D, 2 * CROSS_W), D),
        "cross_w_o": w(ks[22], (L, CROSS_W, D), CROSS_W),
        "ffn2_norm": gain(ks[23], (L, D)),
        "ffn2_w_gate": w(ks[24], (L, D, D_FF), D),
        "ffn2_w_up": w(ks[25], (L, D, D_FF), D),
        "ffn2_w_down": w(ks[26], (L, D_FF, D), D_FF),
        "final_norm": gain(ks[27], (D,)),
    }


def reference(x, mem, positions, ffn1_norm, ffn1_w_gate, ffn1_w_up, ffn1_w_down,
              mix_norm, mix_w_in, forget_bias, conv_w, conv_b,
              lambda_q1, lambda_k1, lambda_q2, lambda_k2, diff_subln, mix_w_out,
              cross_norm, mem_norm, cross_w_q, cross_w_kv, cross_w_o,
              ffn2_norm, ffn2_w_gate, ffn2_w_up, ffn2_w_down, final_norm):
    B, S, _ = x.shape
    inv_freq = ROPE_THETA ** (-jnp.arange(0, ROT_DIM, 2, dtype=jnp.float32) / ROT_DIM)
    ang = positions.astype(jnp.float32)[..., None] * inv_freq
    cos = jnp.cos(ang)[:, :, None, None, :]
    sin = jnp.sin(ang)[:, :, None, None, :]

    h = x
    for l in range(DEPTH):
        h = h + 0.5 * swiglu(rmsnorm(h, ffn1_norm[l]), ffn1_w_gate[l], ffn1_w_up[l], ffn1_w_down[l])

        n = rmsnorm(h, mix_norm[l])
        proj = n @ mix_w_in[l]
        fq, fk, fv, ff, dq, dk, dv, gb, gc, hc = jnp.split(proj, IN_SPLITS, axis=-1)

        log_f = jax.nn.log_sigmoid(ff.astype(jnp.float32) + forget_bias[l].astype(jnp.float32))
        fox = fox_attention(fq.reshape(B, S, FOX_HEADS, FOX_HEAD_DIM),
                            fk.reshape(B, S, FOX_HEADS, FOX_HEAD_DIM),
                            fv.reshape(B, S, FOX_HEADS, FOX_HEAD_DIM), log_f)
        fox = fox.reshape(B, S, FOX_W)

        lam_init = 0.8 - 0.6 * math.exp(-0.3 * l)
        lam = (jnp.exp(jnp.sum(lambda_q1[l].astype(jnp.float32) * lambda_k1[l].astype(jnp.float32)))
               - jnp.exp(jnp.sum(lambda_q2[l].astype(jnp.float32) * lambda_k2[l].astype(jnp.float32)))
               + lam_init)
        dq = partial_rope(dq.reshape(B, S, DIFF_HEADS, 2, DIFF_QK_DIM), cos, sin)
        dk = partial_rope(dk.reshape(B, S, DIFF_HEADS, 2, DIFF_QK_DIM), cos, sin)
        diff = diff_attention(dq, dk, dv.reshape(B, S, DIFF_HEADS, DIFF_V_DIM), lam)
        diff = (rmsnorm(diff, diff_subln[l]) * (1.0 - lam_init)).reshape(B, S, DIFF_V_W)

        conv = gb * causal_depthwise_conv(gc * hc, conv_w[l], conv_b[l])

        mixed = jnp.concatenate([fox, diff, conv], axis=-1) @ mix_w_out[l]
        h = h + mixed

        h = h + cross_attention(rmsnorm(h, cross_norm[l]), rmsnorm(mem, mem_norm[l]),
                                cross_w_q[l], cross_w_kv[l], cross_w_o[l])

        h = h + 0.5 * swiglu(rmsnorm(h, ffn2_norm[l]), ffn2_w_gate[l], ffn2_w_up[l], ffn2_w_down[l])

    return rmsnorm(h, final_norm)
```

```cpp
#include <hip/hip_runtime.h>
#include <hip/hip_bf16.h>
#include <cstdio>
#include <cstdint>

#ifndef MK_ONE_LAUNCH
#define MK_ONE_LAUNCH 1
#endif
__device__ __forceinline__ int opaque_tid() { int t = (int)threadIdx.x; asm volatile("" : "+v"(t)); return t; }
namespace pg8 {
#define PG8_LAS __attribute__((address_space(3)))
typedef unsigned short bf16_t;
typedef short bf16x8 __attribute__((ext_vector_type(8)));
typedef float f32x4 __attribute__((ext_vector_type(4)));
typedef unsigned u32x4 __attribute__((ext_vector_type(4)));
constexpr int BM = 256, BK = 64, HALF = 128, HTB = HALF * BK * 2  , STAGE_BYTES = 8 * HTB, NXCD = 8, WGM = 8;

__host__ __device__ __forceinline__ int lds_byte(int r, int c) { const int st = (r >> 4) * 2 + (c >> 5), rr = r & 15, cc = c & 31, ob = rr * 64 + cc * 2; return st * 1024 + (ob ^ (((ob >> 9) & 1) << 5)); }
__host__ __device__ __forceinline__ void stage_rc(int b, int& R, int& C) { const int st = b / 1024, sb = b % 1024, swz = sb ^ (((sb >> 9) & 1) << 5); R = (st >> 1) * 16 + swz / 64; C = (st & 1) * 32 + (swz % 64) / 2; }
__host__ __device__ __forceinline__ int perm32(int rho) { const int n = rho >> 4, i = rho & 15; return 8 * (i >> 2) + 4 * n + (i & 3); }

struct Unit { int pm, pn; };
struct Gemm { const bf16_t* A; const bf16_t* Bt; int M, N, K; };

struct StaticOrder {
    int nM, nN, nwg, G, c, fixedp;
    __host__ __device__ void init(int M, int N, int G_, int c_) { nM = M / BM; nN = N / BM; nwg = nM * nN; G = G_; c = c_; fixedp = 0; }
    __host__ __device__ bool next(int i, Unit& u) const {
        const long L = (long)i * G + c; if (L >= nwg) return false;
        int wgid = (int)L; { const int q = nwg / NXCD, r = nwg % NXCD, xcd = wgid % NXCD, off = wgid / NXCD; wgid = (xcd < r ? xcd * (q + 1) : r * (q + 1) + (xcd - r) * q) + off; }
        const int nig = WGM * nN, gid = wgid / nig, fm = gid * WGM, gsz = (nM - fm) < WGM ? (nM - fm) : WGM;
        u.pm = fm + ((wgid % nig) % gsz); u.pn = (wgid % nig) / gsz; return true;
    }
    __device__ __forceinline__ void a_ready(const Unit&) const {}
    __device__ __forceinline__ void done(const Unit&) const {}
    __device__ __forceinline__ const char* aptr(const Gemm& g, const Unit& u, size_t tstep) const { return (const char*)g.A + (fixedp ? (size_t)0 : (size_t)u.pm * tstep); }
    __device__ __forceinline__ const char* bptr(const Gemm& g, const Unit& u, size_t tstep) const { return (const char*)g.Bt + (fixedp ? (size_t)0 : (size_t)u.pn * tstep); }
};

__device__ __forceinline__ unsigned cvt_pk_bf16(float lo, float hi) { unsigned r; asm volatile("v_cvt_pk_bf16_f32 %0, %1, %2" : "=v"(r) : "v"(lo), "v"(hi)); return r; }
typedef float f32x2 __attribute__((ext_vector_type(2)));

constexpr float SSQ_FIX = 1048576.0f, SSQ_UNFIX = 1.0f / 1048576.0f;
struct RowScale {
    const unsigned long long* ssq; PG8_LAS float* rs;
    __device__ __forceinline__ unsigned long long rs_load(int pm, int tid) const { return (ssq && tid < BM) ? ssq[pm * BM + tid] : 0ull; }
    __device__ __forceinline__ void rs_store(unsigned long long v, int par, int tid) const { if (tid < BM) rs[(par & 1) * BM + tid] = ssq ? __builtin_amdgcn_rsqf((float)v * (SSQ_UNFIX / 2048.0f) + 1e-6f) : 1.0f; }
    __device__ __forceinline__ void get(int ui, int wr, int fr, float (&r)[2][4]) const {
#pragma unroll
        for (int ai = 0; ai < 2; ++ai)
#pragma unroll
            for (int m = 0; m < 4; ++m) r[ai][m] = rs[(ui & 1) * BM + ai * HALF + wr * 64 + m * 16 + fr]; }
};
struct EpiBf16 : RowScale {
    static constexpr bool PERM = true, AFTER_DRAIN = false, ROWSCALE = true;
    bf16_t* O; int ldc; const float* rope; int rope_lo, rope_hi;
    __device__ __forceinline__ void operator()(const f32x4 (&acc)[2][2][4][2], const Unit& u, int wr, int wc, int fr, int fq, int ui) const {
        const int row0 = u.pm * BM + wr * 64 + fr; const int col0 = u.pn * BM + wc * 32 + 8 * fq;
        float rsv[2][4]; get(ui, wr, fr, rsv);
        const bool rot = rope != nullptr && u.pn >= rope_lo && u.pn < rope_hi && (wc & 1) == 0;
#pragma unroll
        for (int ai = 0; ai < 2; ++ai)
#pragma unroll
            for (int m = 0; m < 4; ++m) { const int row = row0 + ai * HALF + m * 16; bf16_t* rowp = O + (size_t)row * ldc + col0; const float r = rsv[ai][m];
                f32x4 cs0 = {1.f, 1.f, 1.f, 1.f}, cs1 = cs0, sn0 = {0.f, 0.f, 0.f, 0.f}, sn1 = sn0;
                if (rot) { const f32x4* tr = (const f32x4*)(rope + (size_t)row * 16); cs0 = tr[0]; cs1 = tr[1]; sn0 = tr[2]; sn1 = tr[3];
                    if (fq == 0) { sn0 = -sn0; sn1 = -sn1; } else if (fq > 1) { cs0 = (f32x4){1.f, 1.f, 1.f, 1.f}; cs1 = cs0; sn0 = (f32x4){0.f, 0.f, 0.f, 0.f}; sn1 = sn0; } }
#pragma unroll
                for (int bj = 0; bj < 2; ++bj) { f32x4 v0 = acc[ai][bj][m][0] * r, v1 = acc[ai][bj][m][1] * r;
                    if (rot) { f32x4 p0, p1;
#pragma unroll
                        for (int e = 0; e < 4; ++e) { p0[e] = __shfl_xor(v0[e], 16); p1[e] = __shfl_xor(v1[e], 16); }
                        v0 = v0 * cs0 + p0 * sn0; v1 = v1 * cs1 + p1 * sn1; }
                    u32x4 w; w.x = cvt_pk_bf16(v0[0], v0[1]); w.y = cvt_pk_bf16(v0[2], v0[3]); w.z = cvt_pk_bf16(v1[0], v1[1]); w.w = cvt_pk_bf16(v1[2], v1[3]);
                    *(u32x4*)(rowp + bj * HALF) = w; } }
    }
};
__device__ __forceinline__ float silu_mul(float g, float u) { return g * u * __builtin_amdgcn_rcpf(1.0f + __builtin_amdgcn_exp2f(-1.4426950408889634f * g)); }
struct EpiSwiglu : RowScale {
    static constexpr bool PERM = true, AFTER_DRAIN = false, ROWSCALE = true;
    bf16_t* O; int ldc;
    __device__ __forceinline__ void operator()(const f32x4 (&acc)[2][2][4][2], const Unit& u, int wr, int wc, int fr, int fq, int ui) const {
        const int row0 = u.pm * BM + wr * 64 + fr; const int col0 = u.pn * HALF + wc * 32 + 8 * fq;
        float rsv[2][4]; get(ui, wr, fr, rsv);
#pragma unroll
        for (int ai = 0; ai < 2; ++ai)
#pragma unroll
            for (int m = 0; m < 4; ++m) { bf16_t* rowp = O + (size_t)(row0 + ai * HALF + m * 16) * ldc + col0; const float r = rsv[ai][m];
                const f32x4 g0 = acc[ai][0][m][0] * r, g1 = acc[ai][0][m][1] * r, u0 = acc[ai][1][m][0] * r, u1 = acc[ai][1][m][1] * r;
                u32x4 w; w.x = cvt_pk_bf16(silu_mul(g0[0], u0[0]), silu_mul(g0[1], u0[1])); w.y = cvt_pk_bf16(silu_mul(g0[2], u0[2]), silu_mul(g0[3], u0[3]));
                w.z = cvt_pk_bf16(silu_mul(g1[0], u1[0]), silu_mul(g1[1], u1[1])); w.w = cvt_pk_bf16(silu_mul(g1[2], u1[2]), silu_mul(g1[3], u1[3]));
                *(u32x4*)rowp = w; }
    }
};
__device__ __forceinline__ float bfl(unsigned w) { return __builtin_bit_cast(float, w << 16); }
__device__ __forceinline__ float bfh(unsigned w) { return __builtin_bit_cast(float, w & 0xffff0000u); }
struct EpiResid {
    static constexpr bool PERM = true, AFTER_DRAIN = false, ROWSCALE = false;
    bf16_t* hb; unsigned long long* ssq; int ldc; float s; PG8_LAS float* red;
    __device__ __forceinline__ void operator()(const f32x4 (&acc)[2][2][4][2], const Unit& u, int wr, int wc, int fr, int fq, int) const {
        const int row0 = u.pm * BM + wr * 64 + fr; const int col0 = u.pn * BM + wc * 32 + 8 * fq;
        u32x4 pre[8][2];
#pragma unroll
        for (int g = 0; g < 8; ++g) { const size_t off = (size_t)(row0 + (g >> 2) * HALF + (g & 3) * 16) * ldc + col0;
#pragma unroll
            for (int bj = 0; bj < 2; ++bj) pre[g][bj] = *(const u32x4*)(hb + off + bj * HALF); }
#pragma unroll
        for (int g = 0; g < 8; ++g) { const int ai = g >> 2, m = g & 3; const size_t off = (size_t)(row0 + ai * HALF + m * 16) * ldc + col0; float q = 0.f;
#pragma unroll
            for (int bj = 0; bj < 2; ++bj) { const u32x4 b = pre[g][bj];
                const f32x4 v0 = (f32x4){bfl(b.x), bfh(b.x), bfl(b.y), bfh(b.y)} + acc[ai][bj][m][0] * s, v1 = (f32x4){bfl(b.z), bfh(b.z), bfl(b.w), bfh(b.w)} + acc[ai][bj][m][1] * s;
                u32x4 w; w.x = cvt_pk_bf16(v0[0], v0[1]); w.y = cvt_pk_bf16(v0[2], v0[3]); w.z = cvt_pk_bf16(v1[0], v1[1]); w.w = cvt_pk_bf16(v1[2], v1[3]);
                *(u32x4*)(hb + off + bj * HALF) = w;
                q += (v0[0] * v0[0] + v0[1] * v0[1]) + (v0[2] * v0[2] + v0[3] * v0[3]) + (v1[0] * v1[0] + v1[1] * v1[1]) + (v1[2] * v1[2] + v1[3] * v1[3]); }
            q += __shfl_xor(q, 16); q += __shfl_xor(q, 32);
            if (fq == 0) red[wc * BM + ai * HALF + wr * 64 + m * 16 + fr] = q; }
        asm volatile("s_waitcnt lgkmcnt(0)" ::: "memory"); __builtin_amdgcn_s_barrier(); asm volatile("" ::: "memory");
        const int t = wr * 256 + wc * 64 + fq * 16 + fr;
        if (t < BM) { const float sum = (red[t] + red[BM + t]) + (red[2 * BM + t] + red[3 * BM + t]);
            (void)__hip_atomic_fetch_add(ssq + u.pm * BM + t, (unsigned long long)(sum * SSQ_FIX), __ATOMIC_RELAXED, __HIP_MEMORY_SCOPE_AGENT); }
        asm volatile("s_waitcnt lgkmcnt(0)" ::: "memory"); __builtin_amdgcn_s_barrier(); asm volatile("" ::: "memory");
    }
};
template <class Epi, class Sched, bool ALIGN_EPI = false, bool SP2 = false>
__device__ __forceinline__ void gemm_phase(PG8_LAS unsigned char* lds, const Gemm g, const Sched& S, const Epi& E) {
    const int tid = opaque_tid(), wid = __builtin_amdgcn_readfirstlane(tid >> 6), lane = tid & 63, wr = wid >> 2, wc = wid & 3, fr = lane & 15, fq = lane >> 4;
    const int K = g.K, nt = K / BK;
    unsigned voffA[2], voffB[2];
#pragma unroll
    for (int i = 0; i < 2; ++i) { int R, C; stage_rc(tid * 16 + i * 8192, R, C); const int Rb = Epi::PERM ? ((R & ~31) + perm32(R & 31)) : R;
        voffA[i] = (unsigned)(R * K + C) * 2u; voffB[i] = (unsigned)(Rb * K + C) * 2u; }
    const size_t kstep = (size_t)(BK * 2);
    const size_t hstep = (size_t)HALF * K * 2;
    const size_t tstep = 2 * hstep;
    const unsigned ldsw = (unsigned)wid * 1024u;
    const int aoff = lds_byte(wr * 64 + fr, fq * 8), boff = lds_byte(wc * 32 + fr, fq * 8);
#define PG8_SA(b, h) (((b) * 2 + (h)) * HTB)
#define PG8_SB(b, h) ((4 + (b) * 2 + (h)) * HTB)
#define PG8_STAGE(bufoff, gbase, voff) do { _Pragma("unroll") for (int _i = 0; _i < 2; ++_i) \
        __builtin_amdgcn_global_load_lds((const unsigned*)((const char*)(gbase) + (voff)[_i]), (PG8_LAS unsigned*)(lds + (bufoff) + ldsw + _i * 8192), 16, 0, 0); } while (0)
#define PG8_LDA(dst, b, h) do { _Pragma("unroll") for (int m = 0; m < 4; ++m) _Pragma("unroll") for (int k = 0; k < 2; ++k) dst[m][k] = *(const PG8_LAS bf16x8*)(lds + PG8_SA(b, h) + aoff + m * 2048 + k * 1024); } while (0)
#define PG8_LDB(dst, b, h) do { _Pragma("unroll") for (int n = 0; n < 2; ++n) _Pragma("unroll") for (int k = 0; k < 2; ++k) dst[n][k] = *(const PG8_LAS bf16x8*)(lds + PG8_SB(b, h) + boff + n * 2048 + k * 1024); } while (0)
#define PG8_MMA(ai, bj, At, Bt) do { __builtin_amdgcn_s_setprio(1); _Pragma("unroll") for (int m = 0; m < 4; ++m) _Pragma("unroll") for (int n = 0; n < 2; ++n) _Pragma("unroll") for (int k = 0; k < 2; ++k) \
        acc[ai][bj][m][n] = __builtin_amdgcn_mfma_f32_16x16x32_bf16(Bt[n][k], At[m][k], acc[ai][bj][m][n], 0, 0, 0); __builtin_amdgcn_s_setprio(0); } while (0)
#define PG8_WAIT_V(n) asm volatile("s_waitcnt vmcnt(" #n ")" ::: "memory")
#define PG8_WAIT_L(n) asm volatile("s_waitcnt lgkmcnt(" #n ")" ::: "memory")
#define PG8_BAR __builtin_amdgcn_s_barrier()
#define PG8_SCHED __builtin_amdgcn_sched_barrier(0)
    Unit cur, nxt; int ui = 0;
    if (!S.next(0, cur)) return;
    f32x4 acc[2][2][4][2];
#pragma unroll
    for (int a = 0; a < 2; ++a)
#pragma unroll
        for (int b = 0; b < 2; ++b)
#pragma unroll
            for (int m = 0; m < 4; ++m)
#pragma unroll
                for (int n = 0; n < 2; ++n) acc[a][b][m][n] = (f32x4){0.f, 0.f, 0.f, 0.f};
    bf16x8 At[4][2], B0[2][2], B1[2][2];
    const char* cA = S.aptr(g, cur, tstep); const char* cB = S.bptr(g, cur, tstep);
    S.a_ready(cur);
    if constexpr (Epi::ROWSCALE) E.rs_store(E.rs_load(cur.pm, tid), 0, tid);
    if constexpr (SP2) {
        PG8_STAGE(PG8_SB(0, 0), cB, voffB); PG8_STAGE(PG8_SB(0, 1), cB + hstep, voffB); PG8_STAGE(PG8_SA(0, 0), cA, voffA); PG8_STAGE(PG8_SA(0, 1), cA + hstep, voffA);
        if (wr == 1) PG8_BAR;
        PG8_WAIT_V(2); PG8_BAR;
        PG8_STAGE(PG8_SB(1, 0), cB + kstep, voffB); PG8_STAGE(PG8_SA(1, 0), cA + kstep, voffA); PG8_STAGE(PG8_SB(1, 1), cB + hstep + kstep, voffB);
        PG8_WAIT_V(6); PG8_BAR;
    } else {
        PG8_STAGE(PG8_SB(0, 0), cB, voffB); PG8_STAGE(PG8_SA(0, 0), cA, voffA); PG8_STAGE(PG8_SB(0, 1), cB + hstep, voffB); PG8_STAGE(PG8_SA(0, 1), cA + hstep, voffA);
        if (wr == 1) PG8_BAR;
        PG8_WAIT_V(4); PG8_BAR;
        PG8_STAGE(PG8_SB(1, 0), cB + kstep, voffB); PG8_STAGE(PG8_SA(1, 0), cA + kstep, voffA); PG8_STAGE(PG8_SB(1, 1), cB + hstep + kstep, voffB);
        PG8_WAIT_V(6); PG8_BAR;
    }
    for (;;) {
        const bool has_next = S.next(ui + 1, nxt);
        const char* nA = has_next ? S.aptr(g, nxt, tstep) : cA; const char* nB = has_next ? S.bptr(g, nxt, tstep) : cB;
        for (int t = 0; t < nt; t += 2) {
            const bool last = (t == nt - 2);
            const char* a1 = cA + (size_t)(t + 1) * kstep;
            const char* a2 = last ? nA : cA + (size_t)(t + 2) * kstep; const char* b2 = last ? nB : cB + (size_t)(t + 2) * kstep;
            const char* a3 = a2 + kstep; const char* b3 = b2 + kstep;
            if (last && has_next) S.a_ready(nxt);
            if constexpr (SP2) {
            PG8_LDB(B0, 0, 0); PG8_LDB(B1, 0, 1); PG8_SCHED; PG8_LDA(At, 0, 0); PG8_STAGE(PG8_SA(1, 1), a1 + hstep, voffA);
            PG8_WAIT_V(8); PG8_WAIT_L(0); PG8_BAR; PG8_MMA(0, 0, At, B0); PG8_MMA(0, 1, At, B1); PG8_BAR; PG8_SCHED;
            PG8_LDA(At, 0, 1); PG8_STAGE(PG8_SB(0, 0), b2, voffB); PG8_STAGE(PG8_SB(0, 1), b2 + hstep, voffB); PG8_STAGE(PG8_SA(0, 0), a2, voffA);
            PG8_WAIT_V(8); PG8_WAIT_L(0); PG8_BAR; PG8_MMA(1, 0, At, B0); PG8_MMA(1, 1, At, B1); PG8_BAR; PG8_SCHED;
            PG8_LDB(B0, 1, 0); PG8_LDB(B1, 1, 1); PG8_SCHED; PG8_LDA(At, 1, 0); PG8_STAGE(PG8_SA(0, 1), a2 + hstep, voffA);
            PG8_WAIT_V(8); PG8_WAIT_L(0); PG8_BAR; PG8_MMA(0, 0, At, B0); PG8_MMA(0, 1, At, B1); PG8_BAR; PG8_SCHED;
            PG8_LDA(At, 1, 1); PG8_STAGE(PG8_SB(1, 0), b3, voffB); PG8_STAGE(PG8_SB(1, 1), b3 + hstep, voffB); PG8_STAGE(PG8_SA(1, 0), a3, voffA);
            PG8_WAIT_V(8); PG8_WAIT_L(0); PG8_BAR; PG8_MMA(1, 0, At, B0); PG8_MMA(1, 1, At, B1); PG8_BAR; PG8_SCHED;
            } else {
            PG8_LDB(B0, 0, 0); PG8_SCHED; PG8_LDA(At, 0, 0); PG8_STAGE(PG8_SA(1, 1), a1 + hstep, voffA);
            PG8_WAIT_L(8); PG8_BAR; PG8_WAIT_L(0); PG8_MMA(0, 0, At, B0); PG8_BAR; PG8_SCHED;
            PG8_LDB(B1, 0, 1); PG8_STAGE(PG8_SB(0, 0), b2, voffB);
            PG8_BAR; PG8_WAIT_L(0); PG8_MMA(0, 1, At, B1); PG8_BAR;
            PG8_LDA(At, 0, 1); PG8_STAGE(PG8_SA(0, 0), a2, voffA);
            PG8_BAR; PG8_WAIT_L(0); PG8_MMA(1, 0, At, B0); PG8_BAR; PG8_SCHED;
            PG8_STAGE(PG8_SB(0, 1), b2 + hstep, voffB);
            PG8_WAIT_V(6); PG8_BAR; PG8_MMA(1, 1, At, B1); PG8_BAR;
            PG8_LDB(B0, 1, 0); PG8_SCHED; PG8_LDA(At, 1, 0); PG8_STAGE(PG8_SA(0, 1), a2 + hstep, voffA);
            PG8_WAIT_L(8); PG8_BAR; PG8_WAIT_L(0); PG8_MMA(0, 0, At, B0); PG8_BAR; PG8_SCHED;
            PG8_LDB(B1, 1, 1); PG8_STAGE(PG8_SB(1, 0), b3, voffB);
            PG8_BAR; PG8_WAIT_L(0); PG8_MMA(0, 1, At, B1); PG8_BAR;
            PG8_LDA(At, 1, 1); PG8_STAGE(PG8_SA(1, 0), a3, voffA);
            PG8_BAR; PG8_WAIT_L(0); PG8_MMA(1, 0, At, B0); PG8_BAR; PG8_SCHED;
            PG8_STAGE(PG8_SB(1, 1), b3 + hstep, voffB);
            PG8_WAIT_V(6); PG8_BAR; PG8_MMA(1, 1, At, B1); PG8_BAR;
            }
        }
        if constexpr (ALIGN_EPI) { if (wr == 0) PG8_BAR; }
        if constexpr (!Epi::AFTER_DRAIN) {
            unsigned long long pend_ = 0ull; if constexpr (Epi::ROWSCALE) pend_ = E.rs_load(has_next ? nxt.pm : cur.pm, tid);
            E(acc, cur, wr, wc, fr, fq, ui);
            if constexpr (Epi::ROWSCALE) E.rs_store(pend_, ui + 1, tid);
            S.done(cur); }
        if (!has_next) break;
#pragma unroll
        for (int a = 0; a < 2; ++a)
#pragma unroll
            for (int b = 0; b < 2; ++b)
#pragma unroll
                for (int m = 0; m < 4; ++m)
#pragma unroll
                    for (int n = 0; n < 2; ++n) acc[a][b][m][n] = (f32x4){0.f, 0.f, 0.f, 0.f};
        cur = nxt; cA = nA; cB = nB; ++ui;
        if constexpr (ALIGN_EPI) { if (wr == 1) PG8_BAR; }
    }
    PG8_WAIT_V(0);
    if constexpr (!ALIGN_EPI) { if (wr == 0) PG8_BAR; }
    PG8_BAR;
    if constexpr (Epi::AFTER_DRAIN) { E.fused(acc, cur, wr, wc, fr, fq, lds, wid, lane); S.done(cur); }
#undef PG8_SA
#undef PG8_SB
#undef PG8_STAGE
#undef PG8_LDA
#undef PG8_LDB
#undef PG8_MMA
#undef PG8_WAIT_V
#undef PG8_WAIT_L
#undef PG8_BAR
#undef PG8_SCHED
}
}

namespace at {
#define AT_LAS __attribute__((address_space(3)))
typedef unsigned short bf16_t;
typedef short bf16x8 __attribute__((ext_vector_type(8)));
typedef short s16x4 __attribute__((ext_vector_type(4)));
typedef float f32x16 __attribute__((ext_vector_type(16)));
typedef float f32x4 __attribute__((ext_vector_type(4)));
typedef unsigned u32x4 __attribute__((ext_vector_type(4)));
constexpr int KVBLK = 64, SHM_V = 16384, SHM_K = 16384;
constexpr int OFF_V = 0, OFF_K = 2 * SHM_V, OFF_BIAS = OFF_K + 2 * SHM_K, OFF_WS = OFF_BIAS + 1024  , OFF_Q = OFF_WS + 8 * 256, OFF_X = 0  , ATT_LDS = OFF_Q + 256;
static_assert(4 * 32 * 128 * 4 <= OFF_BIAS, "exchange fits the tile buffers");
constexpr float THR = 8.f;
#ifdef PROBE_DUP
constexpr bool AT_PROBE_MFMA2 = (PROBE_DUP & 1024) != 0, AT_PROBE_VALU = (PROBE_DUP & 2048) != 0, AT_PROBE_BAR = (PROBE_DUP & 32768) != 0;
#else
constexpr bool AT_PROBE_MFMA2 = false, AT_PROBE_VALU = false, AT_PROBE_BAR = false;
#endif

#define KSWZ(row, colB) ((row) * 256 + ((colB) ^ (((row) & 7) << 4)))
#define SBAR() __builtin_amdgcn_sched_barrier(0)
__device__ __forceinline__ int v_st(int k, int c) { const int kk = (k & ~0xC) | ((k & 4) << 1) | ((k & 8) >> 1); return ((kk >> 3) * 4 + (c >> 5)) * 512 + ((kk & 7) * 32 + (c & 31)) * 2; }
__device__ __forceinline__ int v_rd_base(int lane) { return ((lane & 3) << 3) | (((lane >> 2) & 3) << 6) | (((lane >> 4) & 1) << 5) | (((lane >> 5) & 1) << 8); }
constexpr int v_rd_off(int d0, int ks, int half) { return d0 * 512 + ks * 4096 + half * 2048; }
__device__ __forceinline__ int crow(int r, int hi) { return (r & 3) + 8 * (r >> 2) + 4 * hi; }
__device__ __forceinline__ unsigned cvtpk(float lo, float hi) { unsigned r; asm volatile("v_cvt_pk_bf16_f32 %0, %1, %2" : "=v"(r) : "v"(lo), "v"(hi)); return r; }

template <int CTRL> __device__ __forceinline__ float dppf(float v) { return __builtin_bit_cast(float, __builtin_amdgcn_update_dpp(0, __builtin_bit_cast(int, v), CTRL, 0xF, 0xF, true)); }
__device__ __forceinline__ float lane_xor1(float v) { return dppf<0xB1>(v); }
__device__ __forceinline__ float sum32(float s) {
    s += dppf<0xB1>(s); s += dppf<0x4E>(s);
    s += dppf<0x141>(s); s += dppf<0x140>(s);
    s += __shfl_xor(s, 16); return s; }
template <int CTRL, int RMASK> __device__ __forceinline__ float dpp0(float v) { return __builtin_bit_cast(float, __builtin_amdgcn_update_dpp(0, __builtin_bit_cast(int, v), CTRL, RMASK, 0xF, false)); }
__device__ __forceinline__ float wave_incl_scan(float x) {
    x += dpp0<0x111, 0xF>(x); x += dpp0<0x112, 0xF>(x); x += dpp0<0x114, 0xF>(x); x += dpp0<0x118, 0xF>(x);
    x += dpp0<0x142, 0xA>(x);
    x += dpp0<0x143, 0xC>(x);
    return x;
}
__device__ __forceinline__ void mask_tile(f32x16& p0, f32x16& p1, int dq, unsigned W) {
    const float NEG = -__builtin_inff();
#pragma unroll
    for (int r = 0; r < 16; ++r) {
        const int c = (r & 3) + 8 * (r >> 2);
        if ((unsigned)(dq - c) >= W) p0[r] = NEG;
        if ((unsigned)(dq - c - 32) >= W) p1[r] = NEG;
    }
}
template <int SCI> struct ScaleOf { static constexpr float v = SCI == 64 ? 0.125f : 0.08838834764831845f; };
template <int SCI>
__device__ __forceinline__ void partialSM(f32x16& p0, f32x16& p1, float& m_reg, float& mn, float& alpha) {
    constexpr float SCALE = ScaleOf<SCI>::v;
    float pmax = p0[0];
#pragma unroll
    for (int r = 1; r < 16; ++r) pmax = fmaxf(pmax, p0[r]);
#pragma unroll
    for (int r = 0; r < 16; ++r) pmax = fmaxf(pmax, p1[r]);
    { auto rr = __builtin_amdgcn_permlane32_swap(__float_as_uint(pmax), __float_as_uint(pmax), false, false);
      pmax = fmaxf(__uint_as_float(rr[0]), __uint_as_float(rr[1])); }
    constexpr float C2 = 1.4426950408889634f * SCALE;
    if (__builtin_expect(__all((pmax - m_reg) * SCALE <= THR), 1)) { mn = m_reg; alpha = 1.f; }
    else { mn = fmaxf(m_reg, pmax); alpha = __builtin_amdgcn_exp2f((m_reg - mn) * C2); m_reg = mn; }
    const float mnL = -mn * C2;
#pragma unroll
    for (int r = 0; r < 16; ++r) p0[r] = fmaf(p0[r], C2, mnL);
#pragma unroll
    for (int r = 0; r < 16; ++r) p1[r] = fmaf(p1[r], C2, mnL);
#pragma unroll
    for (int r = 0; r < 16; ++r) p0[r] = __builtin_amdgcn_exp2f(p0[r]);
}
__device__ __forceinline__ void finishSM(f32x16& p0, f32x16& p1, float alpha, float& l_reg, bf16x8& pa0, bf16x8& pa1, bf16x8& pa2, bf16x8& pa3) {
#pragma unroll
    for (int r = 0; r < 16; ++r) p1[r] = __builtin_amdgcn_exp2f(p1[r]);
    float ps = 0;
#pragma unroll
    for (int r = 0; r < 16; ++r) ps += p0[r];
#pragma unroll
    for (int r = 0; r < 16; ++r) ps += p1[r];
    { auto rr = __builtin_amdgcn_permlane32_swap(__float_as_uint(ps), __float_as_uint(ps), false, false);
      ps = __uint_as_float(rr[0]) + __uint_as_float(rr[1]); }
    l_reg = l_reg * alpha + ps;
#define PK4(P, B_, OUT) do { unsigned a0 = cvtpk(P[B_+0], P[B_+1]), a1 = cvtpk(P[B_+2], P[B_+3]);                          \
        unsigned b0 = cvtpk(P[B_+4], P[B_+5]), b1 = cvtpk(P[B_+6], P[B_+7]);                                             \
        auto r0 = __builtin_amdgcn_permlane32_swap(a0, b0, false, false); auto r1 = __builtin_amdgcn_permlane32_swap(a1, b1, false, false); \
        u32x4 w = {r0[0], r1[0], r0[1], r1[1]}; OUT = *reinterpret_cast<bf16x8*>(&w); } while (0)
    PK4(p0, 0, pa0); PK4(p0, 8, pa1); PK4(p1, 0, pa2); PK4(p1, 8, pa3);
#undef PK4
}
template <int NK, int KB>
__device__ __forceinline__ void qkt(f32x16& p0, f32x16& p1, const AT_LAS char* K_lds, int r32, int hi, const bf16x8* qr) {
    p0 = f32x16{}; p1 = f32x16{};
    const AT_LAS char* kb[4];
#pragma unroll
    for (int dd = 0; dd < 4; ++dd) kb[dd] = K_lds + KB * SHM_K + KSWZ(r32, (dd * 16 + hi * 8) * 2);
#pragma unroll
    for (int d0 = 0; d0 < NK; ++d0) { const AT_LAS char* a = kb[d0 & 3] + (d0 >> 2) * 128;
        const bf16x8 b0 = *reinterpret_cast<const AT_LAS bf16x8*>(a);
        const bf16x8 b1 = *reinterpret_cast<const AT_LAS bf16x8*>(a + 32 * 256);
        p0 = __builtin_amdgcn_mfma_f32_32x32x16_bf16(b0, qr[d0], p0, 0, 0, 0);
        p1 = __builtin_amdgcn_mfma_f32_32x32x16_bf16(b1, qr[d0], p1, 0, 0, 0); }
}
template <int D0, int KB>
__device__ __forceinline__ void qkt_load4(bf16x8 (&kf)[8], const AT_LAS char* K_lds, int r32, int hi) {
#pragma unroll
    for (int dd = 0; dd < 4; ++dd) { const AT_LAS char* a = K_lds + KB * SHM_K + KSWZ(r32, (dd * 16 + hi * 8) * 2) + (D0 >> 2) * 128;
        kf[2 * dd] = *reinterpret_cast<const AT_LAS bf16x8*>(a); kf[2 * dd + 1] = *reinterpret_cast<const AT_LAS bf16x8*>(a + 32 * 256); }
}
template <int D0>
__device__ __forceinline__ void qkt_mfma4(f32x16& p0, f32x16& p1, const bf16x8 (&kf)[8], const bf16x8* qr) {
#pragma unroll
    for (int dd = 0; dd < 4; ++dd) {
        p0 = __builtin_amdgcn_mfma_f32_32x32x16_bf16(kf[2 * dd], qr[D0 + dd], p0, 0, 0, 0);
        p1 = __builtin_amdgcn_mfma_f32_32x32x16_bf16(kf[2 * dd + 1], qr[D0 + dd], p1, 0, 0, 0); }
}
template <int VB>
__device__ __forceinline__ void pv_tile(f32x16* o, int vb0, bf16x8 pa0, bf16x8 pa1, bf16x8 pa2, bf16x8 pa3) {
#define TRRD(dst, off) asm volatile("ds_read_b64_tr_b16 %0, %1 offset:%2" : "=&v"(dst) : "v"(vb0), "i"(off) : "memory")
#define PV_D0(d0) do { s16x4 l0, l1, l2, l3, h0, h1, h2, h3; constexpr int b_ = VB * SHM_V + v_rd_off(d0, 0, 0);     \
        TRRD(l0, b_); TRRD(h0, b_ + 2048); TRRD(l1, b_ + 4096); TRRD(h1, b_ + 6144); TRRD(l2, b_ + 8192); TRRD(h2, b_ + 10240); TRRD(l3, b_ + 12288); TRRD(h3, b_ + 14336); \
        asm volatile("s_waitcnt lgkmcnt(0)" ::: "memory"); SBAR();                                                                                   \
        o[d0] = __builtin_amdgcn_mfma_f32_32x32x16_bf16(pa0, (bf16x8){l0[0], l0[1], l0[2], l0[3], h0[0], h0[1], h0[2], h0[3]}, o[d0], 0, 0, 0);   \
        o[d0] = __builtin_amdgcn_mfma_f32_32x32x16_bf16(pa1, (bf16x8){l1[0], l1[1], l1[2], l1[3], h1[0], h1[1], h1[2], h1[3]}, o[d0], 0, 0, 0);   \
        o[d0] = __builtin_amdgcn_mfma_f32_32x32x16_bf16(pa2, (bf16x8){l2[0], l2[1], l2[2], l2[3], h2[0], h2[1], h2[2], h2[3]}, o[d0], 0, 0, 0);   \
        o[d0] = __builtin_amdgcn_mfma_f32_32x32x16_bf16(pa3, (bf16x8){l3[0], l3[1], l3[2], l3[3], h3[0], h3[1], h3[2], h3[3]}, o[d0], 0, 0, 0); } while (0)
    PV_D0(0); PV_D0(1); PV_D0(2); PV_D0(3);
#undef PV_D0
#undef TRRD
}

template <int MODE>
__device__ __forceinline__ void attn_unit(AT_LAS char* lds, const bf16_t* Qp, int qpitch, const bf16_t* Kp, const bf16_t* Vp, int kvpitch, const float* cb, int q0, int NT,
                                          bf16_t* Op, int opitch, float lam, const float* subg, float outscale) {
    constexpr int NK = (MODE == 1) ? 4 : 8, SCI = (MODE == 1) ? 64 : 128;
    const int tid = opaque_tid(), wid = __builtin_amdgcn_readfirstlane(tid >> 6), lane = tid & 63, r32 = lane & 31, hi = lane >> 5;
    const int comp = (MODE == 1) ? (wid >> 2) : 0;
    const int wrow = (MODE == 1) ? (wid & 3) * 32 : wid * 32;
    bf16x8 qr[NK];
    { const bf16_t* qrow = Qp + (size_t)(wrow + r32) * qpitch + comp * 64 + hi * 8;
#pragma unroll
      for (int d0 = 0; d0 < NK; ++d0) qr[d0] = *reinterpret_cast<const bf16x8*>(qrow + d0 * 16); }
    AT_LAS char* V_lds = lds + OFF_V; AT_LAS char* K_lds = lds + OFF_K; AT_LAS float* bias_l = (AT_LAS float*)(lds + OFF_BIAS);
    AT_LAS float* ws = (AT_LAS float*)(lds + OFF_WS) + wid * 64; AT_LAS float* li_l = ws; AT_LAS float* al_l = ws + 32;
    const int sr = tid >> 4, sc = (tid & 15) * 8;
    const int vst0 = v_st(sr, sc), vst1 = v_st(32 + sr, sc), kws = KSWZ(sr, sc * 2);
    const int vb0 = (int)(unsigned)(uintptr_t)V_lds + v_rd_base(lane);
    const AT_LAS char* Kq = K_lds + comp * 128;
    const int qlo = q0 + wrow, qm = qlo + r32 - 4 * hi;
    float m_reg = -1e30f, l_reg = 0.f; f32x16 o[4];
#pragma unroll
    for (int d = 0; d < 4; ++d) o[d] = f32x16{};
    bf16x8 st_k0, st_k1, st_v0, st_v1; float st_b = 0.f, carry = 0.f;
    constexpr float BSC = -11.313708498984761f;
#define AT_SLOAD(i) do { if ((i) + 2 < NT) { const size_t r0_ = (size_t)(((i) + 2) * KVBLK + sr) * kvpitch + sc, r1_ = r0_ + (size_t)32 * kvpitch;              \
            st_k0 = *reinterpret_cast<const bf16x8*>(Kp + r0_); st_k1 = *reinterpret_cast<const bf16x8*>(Kp + r1_);                                     \
            if (MODE == 0) { if (tid < 64) st_b = cb[((i) + 2) * KVBLK + tid]; } }                                                                      \
        if ((i) + 1 < NT) { const size_t r0_ = (size_t)(((i) + 1) * KVBLK + sr) * kvpitch + sc, r1_ = r0_ + (size_t)32 * kvpitch;                      \
            st_v0 = *reinterpret_cast<const bf16x8*>(Vp + r0_); st_v1 = *reinterpret_cast<const bf16x8*>(Vp + r1_); } } while (0)
#define AT_SWRITE(i, KB  ) do {                                                                                                           \
        if ((i) + 1 < NT) { *reinterpret_cast<AT_LAS bf16x8*>(K_lds + (1 - (KB)) * SHM_K + kws) = st_k0; *reinterpret_cast<AT_LAS bf16x8*>(K_lds + (1 - (KB)) * SHM_K + kws + 32 * 256) = st_k1; \
            if (MODE == 0) { if (tid < 64) { const float c_ = carry + wave_incl_scan(st_b); bias_l[(((i) + 1) & 3) * 64 + tid] = c_ * BSC; carry = __builtin_bit_cast(float, __builtin_amdgcn_readlane(__builtin_bit_cast(int, c_), 63)); } } }   \
        if ((i) < NT) { *reinterpret_cast<AT_LAS bf16x8*>(V_lds + (KB) * SHM_V + vst0) = st_v0; *reinterpret_cast<AT_LAS bf16x8*>(V_lds + (KB) * SHM_V + vst1) = st_v1; } } while (0)
#define AT_RESC(a) do { if (__any((a) < 1.f)) { if (hi == 0) al_l[r32] = (a); asm volatile("s_waitcnt lgkmcnt(0)" ::: "memory");                        \
        _Pragma("unroll") for (int d_ = 0; d_ < 4; ++d_) _Pragma("unroll") for (int r = 0; r < 16; ++r) o[d_][r] *= al_l[crow(r, hi)]; } } while (0)
#define AT_ITER(i, KB) do {                                                                                                                              \
        AT_SWRITE(i, KB); AT_SLOAD(i); SBAR();                                                                                                          \
        if ((i) < NT) { qkt_load4<0, KB>(kf, Kq, r32, hi); SBAR(); }         \
        if ((i) >= 1) pv_tile<1 - (KB)>(o, vb0, pa0, pa1, pa2, pa3);                                                                                    \
        if ((i) < NT) { SBAR(); p0 = f32x16{}; p1 = f32x16{}; qkt_mfma4<0>(p0, p1, kf, qr);                                                             \
            if (NK == 8) { qkt_load4<4, KB>(kf, Kq, r32, hi); qkt_mfma4<(NK == 8 ? 4 : 0)>(p0, p1, kf, qr); } }                                         \
        if (AT_PROBE_MFMA2) { if ((i) < NT) { asm volatile("" : "+v"(p0), "+v"(p1));     \
            qkt_load4<0, KB>(kf, Kq, r32, hi); p0 = f32x16{}; p1 = f32x16{}; qkt_mfma4<0>(p0, p1, kf, qr);                                             \
            if (NK == 8) { qkt_load4<4, KB>(kf, Kq, r32, hi); qkt_mfma4<(NK == 8 ? 4 : 0)>(p0, p1, kf, qr); } } }                                       \
        SBAR(); __syncthreads();                                                                                                                        \
        if ((i) < NT) {                                                                                                                                 \
            if (MODE == 0) { const AT_LAS float* bl = bias_l + ((i) & 3) * 64 + 4 * hi;                                                                \
                _Pragma("unroll") for (int g = 0; g < 4; ++g) { const f32x4 b0_ = *reinterpret_cast<const AT_LAS f32x4*>(bl + 8 * g), b1_ = *reinterpret_cast<const AT_LAS f32x4*>(bl + 32 + 8 * g); \
                    _Pragma("unroll") for (int e = 0; e < 4; ++e) { p0[4 * g + e] += b0_[e]; p1[4 * g + e] += b1_[e]; } } }                          \
            if (MODE != 2) { const int kb_ = (i) * KVBLK; if (kb_ + KVBLK - 1 > qlo) mask_tile(p0, p1, qm - kb_, 0x7fffffffu); }                       \
            if (AT_PROBE_VALU) { float dm_ = 0.f; _Pragma("unroll") for (int q_ = 0; q_ < 128; ++q_) asm volatile("v_add_f32 %0, %0, %0" : "+v"(dm_)); }     \
            float mn_, al_; partialSM<SCI>(p0, p1, m_reg, mn_, al_);                                                                                   \
            finishSM(p0, p1, al_, l_reg, pa0, pa1, pa2, pa3);                                                                                           \
            AT_RESC(al_); }                                                                                                                             \
        SBAR(); __syncthreads(); if (AT_PROBE_BAR) { __syncthreads(); __syncthreads(); } } while (0)
#ifndef AT_GRP_BY_PARITY
#define AT_GRP_BY_PARITY 0
#endif
    const bool grpA = AT_GRP_BY_PARITY ? (wid & 1) == 0 : wid < 4;
    f32x16 p0, p1; bf16x8 pa0, pa1, pa2, pa3; bf16x8 kf[8];
    { const size_t r0_ = (size_t)sr * kvpitch + sc, r1_ = r0_ + (size_t)32 * kvpitch;
      st_k0 = *reinterpret_cast<const bf16x8*>(Kp + r0_); st_k1 = *reinterpret_cast<const bf16x8*>(Kp + r1_);
      if (MODE == 0) { if (tid < 64) st_b = cb[tid]; }
      asm volatile("s_waitcnt vmcnt(0)" ::: "memory");
      *reinterpret_cast<AT_LAS bf16x8*>(K_lds + kws) = st_k0; *reinterpret_cast<AT_LAS bf16x8*>(K_lds + kws + 32 * 256) = st_k1;
      if (MODE == 0) { if (tid < 64) { const float c_ = wave_incl_scan(st_b); bias_l[tid] = c_ * BSC; carry = __builtin_bit_cast(float, __builtin_amdgcn_readlane(__builtin_bit_cast(int, c_), 63)); } } }
    AT_SLOAD(-1);
    __syncthreads();
    if (!grpA) __syncthreads();
    for (int i = 0; i < NT; i += 2) { AT_ITER(i, 0); AT_ITER(i + 1, 1); }
    AT_ITER(NT, 0);
    if (grpA) __syncthreads();
#undef AT_ITER
#undef AT_RESC
#undef AT_SWRITE
#undef AT_SLOAD
    if (hi == 0) li_l[r32] = l_reg;
    asm volatile("s_waitcnt lgkmcnt(0)" ::: "memory");
    float rli[16];
#pragma unroll
    for (int r = 0; r < 16; ++r) rli[r] = __builtin_amdgcn_rcpf(li_l[crow(r, hi)]);
    bf16_t* Ow = Op + (size_t)wrow * opitch;
    if (MODE != 1) {
#pragma unroll
        for (int r = 0; r < 16; ++r) { const int orow = crow(r, hi);
#pragma unroll
            for (int d0 = 0; d0 < 4; ++d0) { const float v = o[d0][r] * rli[r]; const float vn = lane_xor1(v);
                if ((r32 & 1) == 0) *(unsigned*)(Ow + (size_t)orow * opitch + d0 * 32 + r32) = cvtpk(v, vn); } }
        __syncthreads();
    } else {
        AT_LAS float* X = (AT_LAS float*)(lds + OFF_X) + (wid & 3) * 4096;
        if (comp == 1) {
#pragma unroll
            for (int r = 0; r < 16; ++r)
#pragma unroll
                for (int d0 = 0; d0 < 4; ++d0) X[crow(r, hi) * 128 + d0 * 32 + r32] = o[d0][r] * rli[r];
        }
        __syncthreads();
        if (comp == 0) {
            float g[4];
#pragma unroll
            for (int d0 = 0; d0 < 4; ++d0) g[d0] = subg[d0 * 32 + r32] * outscale;
#pragma unroll
            for (int r = 0; r < 16; ++r) { const int orow = crow(r, hi); float dv[4]; float s = 0.f;
#pragma unroll
                for (int d0 = 0; d0 < 4; ++d0) { dv[d0] = o[d0][r] * rli[r] - lam * X[orow * 128 + d0 * 32 + r32]; s += dv[d0] * dv[d0]; }
                s = sum32(s);
                const float rms = 1.0f / sqrtf(s * (1.0f / 128.0f) + 1e-6f);
#pragma unroll
                for (int d0 = 0; d0 < 4; ++d0) { const float v = dv[d0] * rms * g[d0]; const float vn = lane_xor1(v);
                    if ((r32 & 1) == 0) *(unsigned*)(Ow + (size_t)orow * opitch + d0 * 32 + r32) = cvtpk(v, vn); } }
        }
        __syncthreads();
    }
}
#undef SBAR
}

constexpr int D = 2048, BATCH = 4, SEQ = 4096, M = BATCH * SEQ, DEPTH = 4, MEMLEN = 256, MMEM = BATCH * MEMLEN;
constexpr int FF = 5632, NGU = 2 * FF, INW = 6150, INP = 6144, CRW = 512, NFH = 6;
constexpr int C_FQ = 0, C_FK = 768, C_FV = 1536, C_DQ = 2304, C_DK = 3072, C_DV = 3840, C_GB = 4608, C_GC = 5120, C_HC = 5632;
constexpr float EPS = 1e-6f;
constexpr int NWAVES = 8, NTHR = 512;
constexpr size_t MiB = 1u << 20;
constexpr size_t WS_CTL = 0, CTL_ZERO_BYTES = 4 * MiB;
constexpr size_t LW_GU1 = 0, LW_D1 = 44 * MiB, LW_GU2 = 66 * MiB, LW_D2 = 110 * MiB, LW_IN = 132 * MiB, LW_OUT = 156 * MiB, LW_Q = 164 * MiB, LW_KV = 166 * MiB, LW_O = 170 * MiB, LW_SIZE = 172 * MiB;
constexpr size_t WS_SSQ = 1 * MiB;
constexpr size_t WS_W = 4 * MiB;
constexpr size_t WS_NB = WS_W + DEPTH * LW_SIZE;
constexpr size_t WS_ACT = WS_NB + 64 * MiB;
constexpr size_t WS_PROJ = WS_ACT + 176 * MiB;
constexpr size_t WS_MIX = WS_PROJ + 192 * MiB;
constexpr size_t WS_QC = WS_MIX + 64 * MiB;
constexpr size_t WS_OC = WS_QC + 16 * MiB;
constexpr size_t WS_KV = WS_OC + 16 * MiB;
constexpr size_t WS_MEMN = WS_KV + 8 * MiB;
constexpr size_t WS_LOGF = WS_MEMN + 16 * MiB;
constexpr size_t WS_CUM = WS_LOGF + 1 * MiB;
constexpr size_t WS_ROPE = WS_CUM + 1 * MiB;
constexpr size_t WS_WFF = WS_ROPE + 1 * MiB;
constexpr size_t WS_END = WS_WFF + 1 * MiB;
static_assert(WS_SSQ + 18 * (size_t)M * 8 <= CTL_ZERO_BYTES, "ssq accumulators inside the memset region");
static_assert((size_t)NGU * D * 2 == 44 * MiB && (size_t)D * FF * 2 == 22 * MiB && (size_t)INP * D * 2 == 24 * MiB && (size_t)M * FF * 2 == 176 * MiB && (size_t)M * INP * 2 == 192 * MiB, "ws map");
constexpr int CW_BAR = 4096;
constexpr int CW_QUEUE = 16384;
constexpr int RING_OFF = 0, RING_BYTES = 131072;
constexpr int LDSCTL_OFF = RING_BYTES, MISC_OFF = LDSCTL_OFF + 320, RED_OFF = LDSCTL_OFF + 1024, RSC_OFF = LDSCTL_OFF + 5120;
constexpr int LDS_BYTES = 147456;
static_assert(at::ATT_LDS <= RING_BYTES, "attention scratch fits the ring region");

#define GAS __attribute__((address_space(1)))
#define LAS __attribute__((address_space(3)))
typedef unsigned short bf16;
typedef unsigned v4u __attribute__((ext_vector_type(4)));
typedef unsigned v2u __attribute__((ext_vector_type(2)));
typedef float f32x4 __attribute__((ext_vector_type(4)));
typedef float f32x2 __attribute__((ext_vector_type(2)));
typedef short bf16x8 __attribute__((ext_vector_type(8)));
typedef GAS unsigned gu32;
#define RLX_AGENT __ATOMIC_RELAXED, __HIP_MEMORY_SCOPE_AGENT
#define LDS_WAIT() asm volatile("s_waitcnt lgkmcnt(0)" ::: "memory")
#define VM_WAIT() asm volatile("s_waitcnt vmcnt(0)" ::: "memory")
__device__ __forceinline__ unsigned f2bf(float f) { unsigned u = __builtin_bit_cast(unsigned, f); return (u + 0x7fffu + ((u >> 16) & 1u)) >> 16; }
__device__ __forceinline__ unsigned pk2(float lo, float hi) { return f2bf(lo) | (f2bf(hi) << 16); }
__device__ __forceinline__ float bf_lo(unsigned w) { return __builtin_bit_cast(float, w << 16); }
__device__ __forceinline__ float bf_hi(unsigned w) { return __builtin_bit_cast(float, w & 0xffff0000u); }
template <int CTRL> __device__ __forceinline__ float dpp_f(float v) { return __builtin_bit_cast(float, __builtin_amdgcn_update_dpp(0, __builtin_bit_cast(int, v), CTRL, 0xF, 0xF, true)); }
__device__ __forceinline__ float wave_sum(float v) {
    v += dpp_f<0xB1>(v); v += dpp_f<0x4E>(v);
    v += dpp_f<0x141>(v); v += dpp_f<0x140>(v);
    v += __shfl_xor(v, 16);
    { auto rr = __builtin_amdgcn_permlane32_swap(__float_as_uint(v), __float_as_uint(v), false, false);
      v = __uint_as_float(rr[0]) + __uint_as_float(rr[1]); }
    return v;
}
#define XB_TMO      128
#define XB_XCNT(j)  (256  + 64 * (j))
#define XB_XSUB(j)  (1280 + 64 * (j))
#define XB_XGEN(j)  (2304 + 64 * (j))
#define XB_TOP      3328
#define XB_TOPGEN   3392
#define XCD_BAR_WORDS 3456
#define XB_SPIN_CAP (1u << 18)

__device__ __forceinline__ unsigned xb_ld(unsigned* p)              { return __hip_atomic_load(p, __ATOMIC_RELAXED, __HIP_MEMORY_SCOPE_AGENT); }
__device__ __forceinline__ unsigned xb_add(unsigned* p, unsigned v) { return __hip_atomic_fetch_add(p, v, __ATOMIC_RELAXED, __HIP_MEMORY_SCOPE_AGENT); }
__device__ __forceinline__ unsigned xb_xcc_id() { return (unsigned)__builtin_amdgcn_s_getreg((3 << 11) | 20) & 0xFu; }
#define XB_SPIN(cond, bar) do { unsigned _sp = 0; while (cond) { __builtin_amdgcn_s_sleep(1); \
    if ((++_sp & 255u) == 0u) { if (xb_ld(&(bar)[XB_TMO])) break; if (_sp > XB_SPIN_CAP) { atomicAdd(&(bar)[XB_TMO], 1u); break; } } } } while (0)

struct XcdBarrier {
    unsigned* bar; unsigned x;
    volatile LAS unsigned* st;
};

__device__ __forceinline__ XcdBarrier xcd_barrier_post(unsigned* bar, volatile LAS unsigned* st) {
    XcdBarrier b; b.bar = bar; b.x = xb_xcc_id(); b.st = st;
    if (threadIdx.x == 0) (void)xb_add(&bar[XB_XCNT(b.x)], 1u);
    return b;
}
__device__ __forceinline__ void xcd_barrier_complete(unsigned* bar, unsigned x, unsigned& nloc, unsigned& nx) {
    const unsigned G = gridDim.x * gridDim.y * gridDim.z;
    unsigned sum, cnt, mine, sp = 0u;
    for (;;) {
        sum = 0u; cnt = 0u; mine = 0u;
#pragma unroll
        for (unsigned j = 0; j < 16; ++j) { const unsigned c = xb_ld(&bar[XB_XCNT(j)]); sum += c; cnt += (c > 0u) ? 1u : 0u; mine = (j == x) ? c : mine; }
        if (sum == G) break;
        __builtin_amdgcn_s_sleep(1);
        if ((++sp & 255u) == 0u) { if (xb_ld(&bar[XB_TMO])) break; if (sp > XB_SPIN_CAP) { atomicAdd(&bar[XB_TMO], 1u); break; } }
    }
    nloc = mine > 0u ? mine : 1u; nx = cnt > 0u ? cnt : 1u;
}

__device__ __forceinline__ void xcd_barrier(const XcdBarrier& b) {
    asm volatile("s_waitcnt vmcnt(0)" ::: "memory");
    __syncthreads();
    if (threadIdx.x == 0) {
        unsigned* bar = b.bar;
        __builtin_amdgcn_s_waitcnt(0);
        unsigned nloc = b.st[0], nx = b.st[1];
        if (nloc == 0u) { xcd_barrier_complete(bar, b.x, nloc, nx); b.st[0] = nloc; b.st[1] = nx; }
        const unsigned old = xb_add(&bar[XB_XSUB(b.x)], 1u);
        const unsigned gen = old / nloc;
        if (old + 1u == (gen + 1u) * nloc) {
            __builtin_amdgcn_fence(__ATOMIC_RELEASE, "agent");
            asm volatile("s_waitcnt vmcnt(0)" ::: "memory");
            const unsigned og = xb_add(&bar[XB_TOP], 1u);
            const unsigned tg = og / nx;
            if (og + 1u == (tg + 1u) * nx) xb_add(&bar[XB_TOPGEN], 1u);
            else XB_SPIN(xb_ld(&bar[XB_TOPGEN]) == tg, bar);
            __builtin_amdgcn_fence(__ATOMIC_ACQUIRE, "agent");
            xb_add(&bar[XB_XGEN(b.x)], 1u);
            asm volatile("s_waitcnt vmcnt(0)" ::: "memory");
        } else {
            XB_SPIN(xb_ld(&bar[XB_XGEN(b.x)]) == gen, bar);
            __builtin_amdgcn_fence(__ATOMIC_ACQUIRE, "agent");
            asm volatile("s_waitcnt vmcnt(0)" ::: "memory");
        }
    }
    __syncthreads();
}

struct Params { const float* in[28]; float* out; unsigned char* ws; int s_lo, s_hi; };
enum { I_X = 0, I_MEM, I_POS, I_F1N, I_F1G, I_F1U, I_F1D, I_MIXN, I_WIN, I_FBIAS, I_CONVW, I_CONVB, I_LQ1, I_LK1, I_LQ2, I_LK2, I_SUBLN, I_WOUT, I_CRN, I_MEMN, I_CWQ, I_CWKV, I_CWO, I_F2N, I_F2G, I_F2U, I_F2D, I_FINN };

__device__ __forceinline__ void tr_item(const float* W, int pitch, int k0, int ncol0, bf16* WT, int K, int drow0, LAS float* scr, int lane, const float* gain) {
#pragma unroll 8
    for (int i = 0; i < 32; ++i) { const int kk = 2 * i + (lane >> 5); scr[kk * 33 + (lane & 31)] = W[(size_t)(k0 + kk) * pitch + ncol0 + (lane & 31)]; }
    LDS_WAIT(); asm volatile("" ::: "memory");
    const int c = lane & 7;
    f32x4 g0 = {1.f, 1.f, 1.f, 1.f}, g1 = g0;
    if (gain) { g0 = *(const GAS f32x4*)(gain + k0 + 8 * c); g1 = *(const GAS f32x4*)(gain + k0 + 8 * c + 4); }
#pragma unroll
    for (int j = 0; j < 4; ++j) { const int n = (lane >> 3) + 8 * j; const LAS float* s = scr + (8 * c) * 33 + n;
        v4u o; o.x = pk2(s[0 * 33] * g0.x, s[1 * 33] * g0.y); o.y = pk2(s[2 * 33] * g0.z, s[3 * 33] * g0.w); o.z = pk2(s[4 * 33] * g1.x, s[5 * 33] * g1.y); o.w = pk2(s[6 * 33] * g1.z, s[7 * 33] * g1.w);
        *(GAS v4u*)(WT + (size_t)(drow0 + n) * K + k0 + 8 * c) = o; }
    LDS_WAIT(); asm volatile("" ::: "memory");
}
constexpr int IT_GU = (D / 64) * (FF / 32), IT_DN = (FF / 64) * (D / 32), IT_INA = (D / 64) * (2304 / 32), IT_INB = (D / 64) * (3840 / 32), IT_OUT = (D / 64) * (D / 32),
              IT_Q = (D / 64) * (CRW / 32), IT_KV = (D / 64) * (2 * CRW / 32), IT_O = (CRW / 64) * (D / 32);
constexpr int IT_LAYER = 4 * IT_GU + 2 * IT_DN + IT_INA + IT_INB + IT_OUT + IT_Q + IT_KV + IT_O;

__device__ __forceinline__ void prologue_weights(const Params& p, LAS unsigned char* lds, int gw, int NGW, int wave, int lane) {
    LAS float* scr = (LAS float*)(lds + RING_OFF + wave * 16384);
    for (int it = gw; it < DEPTH * IT_LAYER; it += NGW) {
        const int l = it / IT_LAYER; int r = it % IT_LAYER;
        bf16* wl = (bf16*)(p.ws + WS_W + (size_t)l * LW_SIZE);
#define GUJOB(IDX, DSTOFF, UP, GIDX) if (r < IT_GU) { const int kb = r / (FF / 32), nb = r % (FF / 32), n0 = 32 * nb;                                                   \
            tr_item(p.in[IDX] + (size_t)l * D * FF, FF, 64 * kb, n0, (bf16*)((unsigned char*)wl + (DSTOFF)), D, (n0 >> 7) * 256 + (n0 & 127) + (UP) * 128, scr, lane, p.in[GIDX] + (size_t)l * D); continue; } r -= IT_GU;
#define PLJOB(CNT, IDX, LSTRIDE, PITCH, KDIM, NBLK, COL0, DSTOFF, DROW0, GAINP) if (r < (CNT)) { const int kb = r / (NBLK), nb = r % (NBLK);                              \
            tr_item(p.in[IDX] + (size_t)l * (LSTRIDE), PITCH, 64 * kb, (COL0) + 32 * nb, (bf16*)((unsigned char*)wl + (DSTOFF)), KDIM, (DROW0) + 32 * nb, scr, lane, GAINP); continue; } r -= (CNT);
        GUJOB(I_F1G, LW_GU1, 0, I_F1N)
        GUJOB(I_F1U, LW_GU1, 1, I_F1N)
        PLJOB(IT_DN, I_F1D, (size_t)FF * D, D, FF, D / 32, 0, LW_D1, 0, nullptr)
        GUJOB(I_F2G, LW_GU2, 0, I_F2N)
        GUJOB(I_F2U, LW_GU2, 1, I_F2N)
        PLJOB(IT_DN, I_F2D, (size_t)FF * D, D, FF, D / 32, 0, LW_D2, 0, nullptr)
        PLJOB(IT_INA, I_WIN, (size_t)D * INW, INW, D, 2304 / 32, 0, LW_IN, 0, p.in[I_MIXN] + (size_t)l * D)
        PLJOB(IT_INB, I_WIN, (size_t)D * INW, INW, D, 3840 / 32, 2310, LW_IN, 2304, p.in[I_MIXN] + (size_t)l * D)
        PLJOB(IT_OUT, I_WOUT, (size_t)D * D, D, D, D / 32, 0, LW_OUT, 0, nullptr)
        PLJOB(IT_Q, I_CWQ, (size_t)D * CRW, CRW, D, CRW / 32, 0, LW_Q, 0, p.in[I_CRN] + (size_t)l * D)
        PLJOB(IT_KV, I_CWKV, (size_t)D * 2 * CRW, 2 * CRW, D, 2 * CRW / 32, 0, LW_KV, 0, nullptr)
        PLJOB(IT_O, I_CWO, (size_t)CRW * D, D, CRW, D / 32, 0, LW_O, 0, nullptr)
#undef GUJOB
#undef PLJOB
    }
}

__device__ __forceinline__ void x_rows(const float* x, bf16* hb, unsigned long long* ssq, int gw, int NGW, int lane) {
    for (int m = gw; m < M; m += NGW) {
        const GAS f32x4* xr = (const GAS f32x4*)(x + (size_t)m * D) + lane;
        f32x4 v[8]; float s = 0.f;
#pragma unroll
        for (int j = 0; j < 8; ++j) { v[j] = xr[64 * j]; s += (v[j].x * v[j].x + v[j].y * v[j].y) + (v[j].z * v[j].z + v[j].w * v[j].w); }
        s = wave_sum(s);
        GAS v2u* o = (GAS v2u*)(hb + (size_t)m * D) + lane;
#pragma unroll
        for (int j = 0; j < 8; ++j) { v2u w; w.x = pk2(v[j].x, v[j].y); w.y = pk2(v[j].z, v[j].w); o[64 * j] = w; }
        if (lane == 0) ssq[m] = (unsigned long long)(s * pg8::SSQ_FIX);
    }
}
__device__ __forceinline__ void ff_rows(const bf16* hb, const unsigned long long* ssq, const LAS float* wff, const float* fbias, float* logfT, int gw, int NGW, int lane) {
    for (int m = gw; m < M; m += NGW) {
        const GAS v2u* xr = (const GAS v2u*)(hb + (size_t)m * D) + lane;
        f32x4 v[8];
#pragma unroll
        for (int j = 0; j < 8; ++j) { const v2u w = xr[64 * j]; v[j] = (f32x4){bf_lo(w.x), bf_hi(w.x), bf_lo(w.y), bf_hi(w.y)}; }
        const float rstd = 1.0f / sqrtf((float)ssq[m] * (pg8::SSQ_UNFIX / D) + EPS);
        float z = 0.f;
#pragma unroll 1
        for (int q = 0; q < 6; ++q) { float a = 0.f;
#pragma unroll
            for (int j = 0; j < 8; ++j) { const f32x4 w = *(const LAS f32x4*)(wff + q * D + 256 * j + 4 * lane); a += (v[j].x * w.x + v[j].y * w.y) + (v[j].z * w.z + v[j].w * w.w); }
            a = wave_sum(a); z = (lane == q) ? a : z; }
        if (lane < 6) {
            z = z * rstd + fbias[lane];
            const float ls = fminf(z, 0.f) - log1pf(expf(-fabsf(z)));
            const int b = m / SEQ, t = m % SEQ; logfT[(size_t)(b * NFH + lane) * SEQ + t] = ls; }
    }
}
__device__ __forceinline__ void out_norm_rows(const bf16* hb, float* out, const float* gain, int gw, int NGW, int lane) {
    f32x4 g[8];
#pragma unroll
    for (int j = 0; j < 8; ++j) g[j] = ((const GAS f32x4*)gain)[lane + 64 * j];
    for (int m = gw; m < M; m += NGW) {
        const GAS v2u* xr = (const GAS v2u*)(hb + (size_t)m * D) + lane;
        f32x4 v[8]; float s = 0.f;
#pragma unroll
        for (int j = 0; j < 8; ++j) { const v2u w = xr[64 * j]; v[j] = (f32x4){bf_lo(w.x), bf_hi(w.x), bf_lo(w.y), bf_hi(w.y)}; s += (v[j].x * v[j].x + v[j].y * v[j].y) + (v[j].z * v[j].z + v[j].w * v[j].w); }
        const float rstd = 1.0f / sqrtf(wave_sum(s) * (1.0f / D) + EPS);
        GAS f32x4* o = (GAS f32x4*)(out + (size_t)m * D) + lane;
#pragma unroll
        for (int j = 0; j < 8; ++j) o[64 * j] = (v[j] * rstd) * g[j];
    }
}

__device__ __forceinline__ void memn_rows(const Params& p, int gw, int NGW, int lane) {
    bf16* dst = (bf16*)(p.ws + WS_MEMN);
    for (int m = gw; m < DEPTH * MMEM; m += NGW) {
        const int l = m / MMEM, r = m % MMEM;
        const GAS f32x4* xr = (const GAS f32x4*)(p.in[I_MEM] + (size_t)r * D) + lane; const GAS f32x4* gr = (const GAS f32x4*)(p.in[I_MEMN] + (size_t)l * D) + lane;
        f32x4 v[8]; float s = 0.f;
#pragma unroll
        for (int j = 0; j < 8; ++j) { v[j] = xr[64 * j]; s += (v[j].x * v[j].x + v[j].y * v[j].y) + (v[j].z * v[j].z + v[j].w * v[j].w); }
        const float rstd = 1.0f / sqrtf(wave_sum(s) * (1.0f / D) + EPS);
        GAS v2u* o = (GAS v2u*)(dst + (size_t)m * D) + lane;
#pragma unroll
        for (int j = 0; j < 8; ++j) { const f32x4 y = (v[j] * rstd) * gr[64 * j]; v2u w; w.x = pk2(y.x, y.y); w.y = pk2(y.z, y.w); o[64 * j] = w; }
    }
}

__device__ __forceinline__ void wff_table(const Params& p, int gtid, int GT) {
    float* tab = (float*)(p.ws + WS_WFF);
    for (int i = gtid; i < DEPTH * D; i += GT) { const int l = i / D, k = i % D; const float g = p.in[I_MIXN][i]; const float* w = p.in[I_WIN] + ((size_t)l * D + k) * INW + 2304;
#pragma unroll
        for (int j = 0; j < NFH; ++j) tab[(l * NFH + j) * D + k] = g * w[j]; }
}
__device__ __forceinline__ float rope_invf(int f) {
    return f == 0 ? 1.0f : f == 1 ? 0.1939227432012558f : f == 2 ? 0.03760603070259094f : f == 3 ? 0.007292664609849453f : f == 4 ? 0.0014142135623842478f : f == 5 ? 0.00027424818836152554f : f == 6 ? 5.318296098266728e-05f : 1.0313386155758053e-05f;
}
__device__ __forceinline__ void rope_table(const Params& p, int gtid, int GT) {
    float* tab = (float*)(p.ws + WS_ROPE); const int* pos = (const int*)p.in[I_POS];
    for (int i = gtid; i < M * 8; i += GT) { const int tok = i >> 3, f = i & 7;
        const float ang = (float)pos[tok] * rope_invf(f);
        double rev = (double)ang * 0.15915494309189535; rev -= __builtin_rint(rev);
        const float fr = (float)rev;
        tab[tok * 16 + f] = __builtin_amdgcn_cosf(fr); tab[tok * 16 + 8 + f] = __builtin_amdgcn_sinf(fr); }
}

__device__ __forceinline__ void scan_seq(const float* logfT, float* cumT, int seq, int lane) {
    const GAS f32x4* src = (const GAS f32x4*)(logfT + (size_t)seq * SEQ + lane * 64);
    f32x4 v[16]; float run = 0.f;
#pragma unroll
    for (int i = 0; i < 16; ++i) v[i] = src[i];
#pragma unroll
    for (int i = 0; i < 16; ++i) { v[i].x += run; v[i].y += v[i].x; v[i].z += v[i].y; v[i].w += v[i].z; run = v[i].w; }
    float inc = run;
#pragma unroll
    for (int o = 1; o < 64; o <<= 1) { const float t = __shfl_up(inc, o); if (lane >= o) inc += t; }
    const float off = inc - run;
    GAS f32x4* dst = (GAS f32x4*)(cumT + (size_t)seq * SEQ + lane * 64);
#pragma unroll
    for (int i = 0; i < 16; ++i) dst[i] = v[i] + off;
}

__device__ __forceinline__ void rope_rows(const Params& p, int gtid, int GT) {
    bf16* proj = (bf16*)(p.ws + WS_PROJ); const float* tab = (const float*)(p.ws + WS_ROPE);
    for (int i = gtid; i < M * 24; i += GT) { const int tok = i / 24, g = i % 24;
        bf16* x = proj + (size_t)tok * INP + (g >= 12 ? C_DK + (g - 12) * 64 : C_DQ + g * 64);
        const v4u a = *(const GAS v4u*)x, b = *(const GAS v4u*)(x + 8);
        const GAS f32x4* tr = (const GAS f32x4*)(tab + tok * 16); const f32x4 c0 = tr[0], c1 = tr[1], s0 = tr[2], s1 = tr[3];
        float x1[8] = {bf_lo(a.x), bf_hi(a.x), bf_lo(a.y), bf_hi(a.y), bf_lo(a.z), bf_hi(a.z), bf_lo(a.w), bf_hi(a.w)};
        float x2[8] = {bf_lo(b.x), bf_hi(b.x), bf_lo(b.y), bf_hi(b.y), bf_lo(b.z), bf_hi(b.z), bf_lo(b.w), bf_hi(b.w)};
        const float cs[8] = {c0.x, c0.y, c0.z, c0.w, c1.x, c1.y, c1.z, c1.w}, sn[8] = {s0.x, s0.y, s0.z, s0.w, s1.x, s1.y, s1.z, s1.w};
        float y1[8], y2[8];
#pragma unroll
        for (int e = 0; e < 8; ++e) { y1[e] = x1[e] * cs[e] - x2[e] * sn[e]; y2[e] = x2[e] * cs[e] + x1[e] * sn[e]; }
        v4u oa, ob; oa.x = pk2(y1[0], y1[1]); oa.y = pk2(y1[2], y1[3]); oa.z = pk2(y1[4], y1[5]); oa.w = pk2(y1[6], y1[7]);
        ob.x = pk2(y2[0], y2[1]); ob.y = pk2(y2[2], y2[3]); ob.z = pk2(y2[4], y2[5]); ob.w = pk2(y2[6], y2[7]);
        *(GAS v4u*)x = oa; *(GAS v4u*)(x + 8) = ob; }
}
__device__ __forceinline__ void conv_rows(const Params& p, int l, int gtid, int GT) {
    const bf16* proj = (const bf16*)(p.ws + WS_PROJ); bf16* mix = (bf16*)(p.ws + WS_MIX);
    const float* cw = p.in[I_CONVW] + (size_t)l * 3 * CRW; const float* cbias = p.in[I_CONVB] + (size_t)l * CRW;
    for (int i = gtid; i < M * 64; i += GT) { const int tok = i >> 6, ch0 = (i & 63) * 8, t = tok % SEQ;
        const bf16* row = proj + (size_t)tok * INP;
        float z[3][8];
#pragma unroll
        for (int d = 0; d < 3; ++d) {
            if (t >= 2 - d) { const bf16* rr = row - (size_t)(2 - d) * INP; const v4u gc = *(const GAS v4u*)(rr + C_GC + ch0), hc = *(const GAS v4u*)(rr + C_HC + ch0);
                z[d][0] = bf_lo(gc.x) * bf_lo(hc.x); z[d][1] = bf_hi(gc.x) * bf_hi(hc.x); z[d][2] = bf_lo(gc.y) * bf_lo(hc.y); z[d][3] = bf_hi(gc.y) * bf_hi(hc.y);
                z[d][4] = bf_lo(gc.z) * bf_lo(hc.z); z[d][5] = bf_hi(gc.z) * bf_hi(hc.z); z[d][6] = bf_lo(gc.w) * bf_lo(hc.w); z[d][7] = bf_hi(gc.w) * bf_hi(hc.w);
            } else {
#pragma unroll
                for (int e = 0; e < 8; ++e) z[d][e] = 0.f; } }
        const v4u gbv = *(const GAS v4u*)(row + C_GB + ch0);
        const float gb[8] = {bf_lo(gbv.x), bf_hi(gbv.x), bf_lo(gbv.y), bf_hi(gbv.y), bf_lo(gbv.z), bf_hi(gbv.z), bf_lo(gbv.w), bf_hi(gbv.w)};
        float y[8];
#pragma unroll
        for (int e = 0; e < 8; ++e) { const int ch = ch0 + e; y[e] = gb[e] * (z[0][e] * cw[ch] + z[1][e] * cw[CRW + ch] + z[2][e] * cw[2 * CRW + ch] + cbias[ch]); }
        v4u o; o.x = pk2(y[0], y[1]); o.y = pk2(y[2], y[3]); o.z = pk2(y[4], y[5]); o.w = pk2(y[6], y[7]);
        *(GAS v4u*)(mix + (size_t)tok * D + 1536 + ch0) = o; }
}

__device__ __forceinline__ int queue_next(unsigned* head, LAS unsigned char* lds) {
    __syncthreads();
    if (opaque_tid() == 0) *(volatile LAS int*)(lds + RING_OFF + at::OFF_Q) = (int)__hip_atomic_fetch_add(head, 1u, RLX_AGENT);
    __syncthreads();
    return *(volatile LAS int*)(lds + RING_OFF + at::OFF_Q);
}
__device__ __forceinline__ int queue8_next(unsigned* heads, int per_queue, int& cur, int& seen, LAS unsigned char* lds) {
    __syncthreads();
    if (opaque_tid() == 0) { int c = cur, s = seen, idx = -1;
        while (s < 8) { idx = (int)__hip_atomic_fetch_add(heads + 64 * c, 1u, RLX_AGENT); if (idx < per_queue) break; idx = -1; c = (c + 1) & 7; ++s; }
        volatile LAS int* q = (volatile LAS int*)(lds + RING_OFF + at::OFF_Q); q[0] = idx; q[1] = c; q[2] = s; }
    __syncthreads();
    volatile LAS int* q = (volatile LAS int*)(lds + RING_OFF + at::OFF_Q);
    cur = q[1]; seen = q[2]; return q[0];
}

__device__ __forceinline__ unsigned queue8_issue(unsigned* heads, int cur) { return opaque_tid() == 0 ? __hip_atomic_fetch_add(heads + 64 * cur, 1u, RLX_AGENT) : 0u; }
__device__ __forceinline__ int queue8_take(unsigned pre, unsigned* heads, int per_queue, int& cur, int& seen, LAS unsigned char* lds) {
    __syncthreads();
    if (opaque_tid() == 0) *(volatile LAS int*)(lds + RING_OFF + at::OFF_Q) = (int)pre;
    __syncthreads();
    int idx = *(volatile LAS int*)(lds + RING_OFF + at::OFF_Q);
    if (idx >= per_queue) idx = queue8_next(heads, per_queue, cur, seen, lds);
    return idx;
}

struct KvOrder : pg8::StaticOrder {
    size_t lstride;
    __device__ __forceinline__ const char* bptr(const pg8::Gemm& g, const pg8::Unit& u, size_t tstep) const { return (const char*)g.Bt + (size_t)(u.pm >> 2) * lstride + (size_t)u.pn * tstep; }
};

#define PHFN __device__ __forceinline__
PHFN void ph_prologue(const Params& p, LAS unsigned char* lds) {
    const int tid = opaque_tid(), lane = tid & 63, wave = __builtin_amdgcn_readfirstlane(tid >> 6);
    const int G = gridDim.x, gw = blockIdx.x * NWAVES + wave, NGW = G * NWAVES, gtid = blockIdx.x * NTHR + tid, GT = G * NTHR;
    prologue_weights(p, lds, gw, NGW, wave, lane);
    rope_table(p, gtid, GT);
    memn_rows(p, gw, NGW, lane);
    wff_table(p, gtid, GT);
    x_rows(p.in[I_X], (bf16*)(p.ws + WS_NB), (unsigned long long*)(p.ws + WS_SSQ), gw, NGW, lane);
}
PHFN void ph_norm_out(const bf16* hb, float* out, const float* gain) {
    const int tid = opaque_tid(), lane = tid & 63, wave = __builtin_amdgcn_readfirstlane(tid >> 6);
    out_norm_rows(hb, out, gain, blockIdx.x * NWAVES + wave, gridDim.x * NWAVES, lane);
}
PHFN void ph_ff(const bf16* h, const unsigned long long* ssq, const float* wfft  , const float* fbias, float* logfT, LAS unsigned char* lds) {
    const int tid = opaque_tid(), lane = tid & 63, wave = __builtin_amdgcn_readfirstlane(tid >> 6);
    LAS float* wff = (LAS float*)(lds + RING_OFF);
    for (int k = tid; k < NFH * D / 4; k += NTHR) ((LAS f32x4*)wff)[k] = ((const GAS f32x4*)wfft)[k];
    __syncthreads();
    ff_rows(h, ssq, wff, fbias, logfT, blockIdx.x * NWAVES + wave, gridDim.x * NWAVES, lane);
    __syncthreads();
}
PHFN void ph_gemm_kv(LAS unsigned char* lds, const bf16* A, const bf16* Bt, bf16* O) {
    pg8::Gemm g{A, Bt, DEPTH * MMEM, 2 * CRW, D};
    KvOrder S; S.init(DEPTH * MMEM, 2 * CRW, gridDim.x, (int)blockIdx.x); S.lstride = LW_SIZE;
    pg8::EpiBf16 E{{nullptr, (LAS float*)(lds + RSC_OFF)}, O, 2 * CRW, nullptr, 0, 0};
    pg8::gemm_phase<pg8::EpiBf16, KvOrder, true, true>(lds + RING_OFF, g, S, E);
}
PHFN void ph_gemm_swiglu(LAS unsigned char* lds, const bf16* A, const bf16* Bt, bf16* O, const unsigned long long* ssq, int fixedp = 0) {
    pg8::Gemm g{A, Bt, M, NGU, D};
    pg8::StaticOrder S; S.init(M, NGU, gridDim.x, (int)blockIdx.x); S.fixedp = fixedp;
    pg8::EpiSwiglu E{{ssq, (LAS float*)(lds + RSC_OFF)}, O, FF};
    pg8::gemm_phase<pg8::EpiSwiglu, pg8::StaticOrder, true, true>(lds + RING_OFF, g, S, E);
}
PHFN void ph_gemm_resid(LAS unsigned char* lds, const bf16* A, const bf16* Bt, int K, bf16* hb, unsigned long long* ssq, float s) {
    pg8::Gemm g{A, Bt, M, D, K};
    pg8::StaticOrder S; S.init(M, D, gridDim.x, (int)blockIdx.x);
    pg8::EpiResid E{hb, ssq, D, s, (LAS float*)(lds + RED_OFF)};
    pg8::gemm_phase<pg8::EpiResid, pg8::StaticOrder, true, true>(lds + RING_OFF, g, S, E);
}
PHFN void ph_gemm_bf16(LAS unsigned char* lds, const bf16* A, const bf16* Bt, int N, bf16* O, const unsigned long long* ssq, const float* rope) {
    pg8::Gemm g{A, Bt, M, N, D};
    pg8::StaticOrder S; S.init(M, N, gridDim.x, (int)blockIdx.x);
    pg8::EpiBf16 E{{ssq, (LAS float*)(lds + RSC_OFF)}, O, N, rope, C_DQ / 256, C_DV / 256};
    pg8::gemm_phase<pg8::EpiBf16, pg8::StaticOrder, true, true>(lds + RING_OFF, g, S, E);
}
PHFN void ph_post(const Params& p) {
    const int tid = opaque_tid(), lane = tid & 63, wave = __builtin_amdgcn_readfirstlane(tid >> 6);
    const int gw = blockIdx.x * NWAVES + wave;
    if (gw < BATCH * NFH) scan_seq((const float*)(p.ws + WS_LOGF), (float*)(p.ws + WS_CUM), gw, lane);
    rope_rows(p, blockIdx.x * NTHR + tid, gridDim.x * NTHR);
}
PHFN void ph_conv(const Params& p, int l) {
    const int tid = opaque_tid();
    conv_rows(p, l, blockIdx.x * NTHR + tid, gridDim.x * NTHR);
}
PHFN void ph_attn_fox(LAS unsigned char* lds, const bf16* PROJ, const float* CUM, bf16* MIX, unsigned* heads) {
    int cur = (int)(xb_xcc_id() & 7u), seen = 0;
    for (int idx = queue8_next(heads, 48, cur, seen, lds); idx >= 0; ) {
        const unsigned pre = queue8_issue(heads, cur);
        const int qb = 15 - idx / 3, bh = (idx % 3) * 8 + cur, b = bh / NFH, h = bh % NFH; const size_t tok0 = (size_t)b * SEQ;
        at::attn_unit<0>((LAS char*)(lds + RING_OFF), PROJ + (tok0 + qb * 256) * INP + C_FQ + h * 128, INP, PROJ + tok0 * INP + C_FK + h * 128, PROJ + tok0 * INP + C_FV + h * 128, INP,
                         CUM + (size_t)(b * NFH + h) * SEQ, qb * 256, 4 * (qb + 1), MIX + (tok0 + qb * 256) * D + h * 128, D, 0.f, nullptr, 0.f);
        idx = queue8_take(pre, heads, 48, cur, seen, lds);
    }
}
PHFN void ph_attn_diff(LAS unsigned char* lds, const bf16* PROJ, bf16* MIX, unsigned* heads, const float* lq1, const float* lk1, const float* lq2, const float* lk2, const float* subg, int l) {
    const int lane = opaque_tid() & 63;
    const float lam_init = 0.8f - 0.6f * expf(-0.3f * (float)l);
    const float lam = expf(wave_sum(lq1[lane] * lk1[lane])) - expf(wave_sum(lq2[lane] * lk2[lane])) + lam_init;
    int cur = (int)(xb_xcc_id() & 7u), seen = 0;
    for (int idx = queue8_next(heads, 96, cur, seen, lds); idx >= 0; ) {
        const unsigned pre = queue8_issue(heads, cur);
        const int qb = 31 - idx / 3, bh = (idx % 3) * 8 + cur, b = bh / NFH, h = bh % NFH; const size_t tok0 = (size_t)b * SEQ;
        at::attn_unit<1>((LAS char*)(lds + RING_OFF), PROJ + (tok0 + qb * 128) * INP + C_DQ + h * 128, INP, PROJ + tok0 * INP + C_DK + h * 128, PROJ + tok0 * INP + C_DV + h * 128, INP,
                         nullptr, qb * 128, 2 * (qb + 1), MIX + (tok0 + qb * 128) * D + 768 + h * 128, D, lam, subg, 1.0f - lam_init);
        idx = queue8_take(pre, heads, 96, cur, seen, lds);
    }
}
PHFN void ph_attn_cross(LAS unsigned char* lds, const bf16* QC, const bf16* KVL  , bf16* OC, unsigned* head) {
    for (;;) {
        const int idx = queue_next(head, lds); if (idx >= 256) break;
        const int qb = idx & 15, bh = idx >> 4, b = bh >> 2, h = bh & 3; const size_t tok0 = (size_t)b * SEQ + qb * 256;
        const bf16* kv = KVL + (size_t)(b * MEMLEN) * (2 * CRW) + h * 128;
        at::attn_unit<2>((LAS char*)(lds + RING_OFF), QC + tok0 * CRW + h * 128, CRW, kv, kv + CRW, 2 * CRW, nullptr, 0, MEMLEN / 64, OC + tok0 * CRW + h * 128, CRW, 0.f, nullptr, 0.f);
    }
}

#ifndef PROBE_DUP
#define PROBE_DUP 0
#endif
constexpr int N_STEPS = 2 + 8 * 2 + DEPTH * 6 + 1;
__global__ void __launch_bounds__(NTHR, 2) fwd(Params p) {
    extern __shared__ __attribute__((aligned(16))) unsigned char lds_raw[];
    LAS unsigned char* lds = (LAS unsigned char*)lds_raw;
    const int tid = threadIdx.x;
    unsigned* ctl = (unsigned*)(p.ws + WS_CTL);
    for (int u = tid; u < (LDS_BYTES - LDSCTL_OFF) / 4; u += NTHR) ((LAS unsigned*)(lds + LDSCTL_OFF))[u] = 0u;
    __syncthreads();
    XcdBarrier bar; bar.bar = ctl + CW_BAR; bar.x = 0; bar.st = nullptr;
    if (p.s_hi - p.s_lo > 1) bar = xcd_barrier_post(ctl + CW_BAR, (volatile LAS unsigned*)(lds + MISC_OFF) + 8);
    int cur = 0;
#define PH_BEGIN if (p.s_lo <= cur && cur < p.s_hi) {
#if PROBE_DUP & 512
#define PH_END   if (cur + 1 < p.s_hi) { xcd_barrier(bar); xcd_barrier(bar); } } ++cur;
#else
#define PH_END   if (cur + 1 < p.s_hi) xcd_barrier(bar); } ++cur;
#endif
    bf16* const HB = (bf16*)(p.ws + WS_NB); unsigned long long* ssq = (unsigned long long*)(p.ws + WS_SSQ);     bf16* const ACT = (bf16*)(p.ws + WS_ACT); bf16* const PROJ = (bf16*)(p.ws + WS_PROJ); bf16* const MIX = (bf16*)(p.ws + WS_MIX);
    bf16* const QC = (bf16*)(p.ws + WS_QC); bf16* const OC = (bf16*)(p.ws + WS_OC); bf16* const KVB = (bf16*)(p.ws + WS_KV);
    float* const LOGF = (float*)(p.ws + WS_LOGF);

    PH_BEGIN ph_prologue(p, lds);
#if PROBE_DUP & 2
        ph_prologue(p, lds);
#endif
    PH_END
    PH_BEGIN ph_gemm_kv(lds, (const bf16*)(p.ws + WS_MEMN), (const bf16*)(p.ws + WS_W + LW_KV), KVB); PH_END
    for (int j = 0; j < 2 * DEPTH; ++j) {
        const int l = j >> 1; const bool second = (j & 1) != 0;
        const unsigned char* wl = p.ws + WS_W + (size_t)l * LW_SIZE;
        PH_BEGIN
#if PROBE_DUP & 8192
            for (int rep = 0; rep < 2; ++rep)
                ph_gemm_swiglu(lds, HB, (const bf16*)(wl + (second ? LW_GU2 : LW_GU1)), rep ? PROJ : ACT, ssq, rep);
#elif PROBE_DUP & 4096
            for (int rep = 0; rep < 2; ++rep) {
                ph_gemm_swiglu(lds, HB, (const bf16*)(wl + (second ? LW_GU2 : LW_GU1)), ACT, ssq); if (rep == 0) xcd_barrier(bar); }
#else
            ph_gemm_swiglu(lds, HB, (const bf16*)(wl + (second ? LW_GU2 : LW_GU1)), ACT, ssq);
#endif
#if PROBE_DUP & 4
            ph_gemm_swiglu(lds, HB, (const bf16*)(wl + (second ? LW_GU2 : LW_GU1)), ACT, ssq);
#endif
        PH_END
        PH_BEGIN ph_gemm_resid(lds, ACT, (const bf16*)(wl + (second ? LW_D2 : LW_D1)), FF, HB, ssq + M, 0.5f);
#if PROBE_DUP & 64
            ph_gemm_resid(lds, ACT, (const bf16*)(wl + (second ? LW_D2 : LW_D1)), FF, HB, (unsigned long long*)(p.ws + WS_SSQ) + 17 * (size_t)M, 0.0f);
#endif
        PH_END
        ssq += M;
        if (!second) {
            PH_BEGIN
                ph_ff(HB, ssq, (const float*)(p.ws + WS_WFF) + (size_t)l * NFH * D, p.in[I_FBIAS] + l * NFH, LOGF, lds);
                ph_gemm_bf16(lds, HB, (const bf16*)(wl + LW_IN), INP, PROJ, ssq, (const float*)(p.ws + WS_ROPE));
#if PROBE_DUP & 32
                ph_gemm_bf16(lds, HB, (const bf16*)(wl + LW_IN), INP, PROJ, ssq, (const float*)(p.ws + WS_ROPE));
#endif
            PH_END
            PH_BEGIN
                ph_attn_fox(lds, PROJ, LOGF, MIX, ctl + CW_QUEUE + 512 * (3 * l));
                ph_attn_diff(lds, PROJ, MIX, ctl + CW_QUEUE + 512 * (3 * l + 1), p.in[I_LQ1] + l * 64, p.in[I_LK1] + l * 64, p.in[I_LQ2] + l * 64, p.in[I_LK2] + l * 64, p.in[I_SUBLN] + l * 128, l);
                ph_conv(p, l);
#if PROBE_DUP & 1
                ph_attn_fox(lds, PROJ, LOGF, MIX, ctl + CW_QUEUE + 512 * (12 + 3 * l));
                ph_attn_diff(lds, PROJ, MIX, ctl + CW_QUEUE + 512 * (12 + 3 * l + 1), p.in[I_LQ1] + l * 64, p.in[I_LK1] + l * 64, p.in[I_LQ2] + l * 64, p.in[I_LK2] + l * 64, p.in[I_SUBLN] + l * 128, l);
#endif
            PH_END
            PH_BEGIN ph_gemm_resid(lds, MIX, (const bf16*)(wl + LW_OUT), D, HB, ssq + M, 1.0f);
#if PROBE_DUP & 128
                ph_gemm_resid(lds, MIX, (const bf16*)(wl + LW_OUT), D, HB, (unsigned long long*)(p.ws + WS_SSQ) + 17 * (size_t)M, 0.0f);
#endif
            PH_END
            ssq += M;
            PH_BEGIN ph_gemm_bf16(lds, HB, (const bf16*)(wl + LW_Q), CRW, QC, ssq, nullptr); PH_END
            PH_BEGIN ph_attn_cross(lds, QC, KVB + (size_t)l * MMEM * 2 * CRW, OC, ctl + CW_QUEUE + 512 * (3 * l + 2));
#if PROBE_DUP & 16
                ph_attn_cross(lds, QC, KVB + (size_t)l * MMEM * 2 * CRW, OC, ctl + CW_QUEUE + 512 * (12 + 3 * l + 2));
#endif
            PH_END
            PH_BEGIN ph_gemm_resid(lds, OC, (const bf16*)(wl + LW_O), CRW, HB, ssq + M, 1.0f);
#if PROBE_DUP & 256
                ph_gemm_resid(lds, OC, (const bf16*)(wl + LW_O), CRW, HB, (unsigned long long*)(p.ws + WS_SSQ) + 17 * (size_t)M, 0.0f);
#endif
            PH_END
            ssq += M;
        }
    }
    PH_BEGIN ph_norm_out(HB, p.out, p.in[I_FINN]); PH_END
#undef PH_BEGIN
#undef PH_END
}

extern "C" void kernel_launch(void* const* d_in, const int* in_sizes, int n_in, void* d_out, int out_size, void* d_ws, size_t ws_size, hipStream_t stream) {
    static int grid = 0;
    if (grid == 0) {
        if (n_in != 28 || in_sizes[0] != M * D || out_size != M * D || ws_size < WS_END) { fprintf(stderr, "kernel_launch: unexpected problem: n_in %d in0 %d out %d ws %zu (need %zu)\n", n_in, n_in > 0 ? in_sizes[0] : -1, out_size, ws_size, (size_t)WS_END); grid = -1; return; }
        int dev = 0, cus = 0, per_cu = 0;
        if (hipGetDevice(&dev) != hipSuccess || hipDeviceGetAttribute(&cus, hipDeviceAttributeMultiprocessorCount, dev) != hipSuccess) { grid = -1; return; }
        if (hipFuncSetAttribute((const void*)fwd, hipFuncAttributeMaxDynamicSharedMemorySize, LDS_BYTES) != hipSuccess) { fprintf(stderr, "kernel_launch: hipFuncSetAttribute failed\n"); grid = -1; return; }
        if (hipOccupancyMaxActiveBlocksPerMultiprocessor(&per_cu, (const void*)fwd, NTHR, LDS_BYTES) != hipSuccess || per_cu < 1) fprintf(stderr, "kernel_launch: occupancy query reports %d\n", per_cu);
        (void)hipGetLastError();
        grid = cus;
    }
    if (grid < 0) return;
    (void)hipMemsetAsync((char*)d_ws + WS_CTL, 0, CTL_ZERO_BYTES, stream);
    Params a{};
    for (int i = 0; i < 28; ++i) a.in[i] = (const float*)d_in[i];
    a.out = (float*)d_out; a.ws = (unsigned char*)d_ws;
#if MK_ONE_LAUNCH
    a.s_lo = 0; a.s_hi = N_STEPS;
    hipLaunchKernelGGL(fwd, dim3(grid), dim3(NTHR), LDS_BYTES, stream, a);
#else
    for (int s = 0; s < N_STEPS; ++s) { a.s_lo = s; a.s_hi = s + 1; hipLaunchKernelGGL(fwd, dim3(grid), dim3(NTHR), LDS_BYTES, stream, a); }
#endif
}
```

```cpp
#include <hip/hip_runtime.h>
#include <hip/hip_bf16.h>
#include <cstdio>
#include <cstdint>

#ifndef MK_ONE_LAUNCH
#define MK_ONE_LAUNCH 1
#endif
__device__ __forceinline__ int opaque_tid() { int t = (int)threadIdx.x; asm volatile("" : "+v"(t)); return t; }
namespace pg8 {
#define PG8_LAS __attribute__((address_space(3)))
typedef unsigned short bf16_t;
typedef short bf16x8 __attribute__((ext_vector_type(8)));
typedef float f32x4 __attribute__((ext_vector_type(4)));
typedef unsigned u32x4 __attribute__((ext_vector_type(4)));
constexpr int BM = 256, BK = 64, HALF = 128, HTB = HALF * BK * 2  , STAGE_BYTES = 8 * HTB, NXCD = 8, WGM = 8;

__host__ __device__ __forceinline__ int lds_byte(int r, int c) { const int st = (r >> 4) * 2 + (c >> 5), rr = r & 15, cc = c & 31, ob = rr * 64 + cc * 2; return st * 1024 + (ob ^ (((ob >> 9) & 1) << 5)); }
__host__ __device__ __forceinline__ void stage_rc(int b, int& R, int& C) { const int st = b / 1024, sb = b % 1024, swz = sb ^ (((sb >> 9) & 1) << 5); R = (st >> 1) * 16 + swz / 64; C = (st & 1) * 32 + (swz % 64) / 2; }
__host__ __device__ __forceinline__ int perm32(int rho) { const int n = rho >> 4, i = rho & 15; return 8 * (i >> 2) + 4 * n + (i & 3); }

struct Unit { int pm, pn; };
struct Gemm { const bf16_t* A; const bf16_t* Bt; int M, N, K; };

struct StaticOrder {
    int nM, nN, nwg, G, c, fixedp;
    __host__ __device__ void init(int M, int N, int G_, int c_) { nM = M / BM; nN = N / BM; nwg = nM * nN; G = G_; c = c_; fixedp = 0; }
    __host__ __device__ bool next(int i, Unit& u) const {
        const long L = (long)i * G + c; if (L >= nwg) return false;
        int wgid = (int)L; { const int q = nwg / NXCD, r = nwg % NXCD, xcd = wgid % NXCD, off = wgid / NXCD; wgid = (xcd < r ? xcd * (q + 1) : r * (q + 1) + (xcd - r) * q) + off; }
        const int nig = WGM * nN, gid = wgid / nig, fm = gid * WGM, gsz = (nM - fm) < WGM ? (nM - fm) : WGM;
        u.pm = fm + ((wgid % nig) % gsz); u.pn = (wgid % nig) / gsz; return true;
    }
    __device__ __forceinline__ void a_ready(const Unit&) const {}
    __device__ __forceinline__ void done(const Unit&) const {}
    __device__ __forceinline__ const char* aptr(const Gemm& g, const Unit& u, size_t tstep) const { return (const char*)g.A + (fixedp ? (size_t)0 : (size_t)u.pm * tstep); }
    __device__ __forceinline__ const char* bptr(const Gemm& g, const Unit& u, size_t tstep) const { return (const char*)g.Bt + (fixedp ? (size_t)0 : (size_t)u.pn * tstep); }
};

__device__ __forceinline__ unsigned cvt_pk_bf16(float lo, float hi) { unsigned r; asm volatile("v_cvt_pk_bf16_f32 %0, %1, %2" : "=v"(r) : "v"(lo), "v"(hi)); return r; }
typedef float f32x2 __attribute__((ext_vector_type(2)));

constexpr float SSQ_FIX = 1048576.0f, SSQ_UNFIX = 1.0f / 1048576.0f;
struct RowScale {
    const unsigned long long* ssq; PG8_LAS float* rs;
    __device__ __forceinline__ unsigned long long rs_load(int pm, int tid) const { return (ssq && tid < BM) ? ssq[pm * BM + tid] : 0ull; }
    __device__ __forceinline__ void rs_store(unsigned long long v, int par, int tid) const { if (tid < BM) rs[(par & 1) * BM + tid] = ssq ? __builtin_amdgcn_rsqf((float)v * (SSQ_UNFIX / 2048.0f) + 1e-6f) : 1.0f; }
    __device__ __forceinline__ void get(int ui, int wr, int fr, float (&r)[2][4]) const {
#pragma unroll
        for (int ai = 0; ai < 2; ++ai)
#pragma unroll
            for (int m = 0; m < 4; ++m) r[ai][m] = rs[(ui & 1) * BM + ai * HALF + wr * 64 + m * 16 + fr]; }
};
struct EpiBf16 : RowScale {
    static constexpr bool PERM = true, AFTER_DRAIN = false, ROWSCALE = true;
    bf16_t* O; int ldc; const float* rope; int rope_lo, rope_hi;
    __device__ __forceinline__ void operator()(const f32x4 (&acc)[2][2][4][2], const Unit& u, int wr, int wc, int fr, int fq, int ui) const {
        const int row0 = u.pm * BM + wr * 64 + fr; const int col0 = u.pn * BM + wc * 32 + 8 * fq;
        float rsv[2][4]; get(ui, wr, fr, rsv);
        const bool rot = rope != nullptr && u.pn >= rope_lo && u.pn < rope_hi && (wc & 1) == 0;
#pragma unroll
        for (int ai = 0; ai < 2; ++ai)
#pragma unroll
            for (int m = 0; m < 4; ++m) { const int row = row0 + ai * HALF + m * 16; bf16_t* rowp = O + (size_t)row * ldc + col0; const float r = rsv[ai][m];
                f32x4 cs0 = {1.f, 1.f, 1.f, 1.f}, cs1 = cs0, sn0 = {0.f, 0.f, 0.f, 0.f}, sn1 = sn0;
                if (rot) { const f32x4* tr = (const f32x4*)(rope + (size_t)row * 16); cs0 = tr[0]; cs1 = tr[1]; sn0 = tr[2]; sn1 = tr[3];
                    if (fq == 0) { sn0 = -sn0; sn1 = -sn1; } else if (fq > 1) { cs0 = (f32x4){1.f, 1.f, 1.f, 1.f}; cs1 = cs0; sn0 = (f32x4){0.f, 0.f, 0.f, 0.f}; sn1 = sn0; } }
#pragma unroll
                for (int bj = 0; bj < 2; ++bj) { f32x4 v0 = acc[ai][bj][m][0] * r, v1 = acc[ai][bj][m][1] * r;
                    if (rot) { f32x4 p0, p1;
#pragma unroll
                        for (int e = 0; e < 4; ++e) { p0[e] = __shfl_xor(v0[e], 16); p1[e] = __shfl_xor(v1[e], 16); }
                        v0 = v0 * cs0 + p0 * sn0; v1 = v1 * cs1 + p1 * sn1; }
                    u32x4 w; w.x = cvt_pk_bf16(v0[0], v0[1]); w.y = cvt_pk_bf16(v0[2], v0[3]); w.z = cvt_pk_bf16(v1[0], v1[1]); w.w = cvt_pk_bf16(v1[2], v1[3]);
                    *(u32x4*)(rowp + bj * HALF) = w; } }
    }
};
__device__ __forceinline__ float silu_mul(float g, float u) { return g * u * __builtin_amdgcn_rcpf(1.0f + __builtin_amdgcn_exp2f(-1.4426950408889634f * g)); }
struct EpiSwiglu : RowScale {
    static constexpr bool PERM = true, AFTER_DRAIN = false, ROWSCALE = true;
    bf16_t* O; int ldc;
    __device__ __forceinline__ void operator()(const f32x4 (&acc)[2][2][4][2], const Unit& u, int wr, int wc, int fr, int fq, int ui) const {
        const int row0 = u.pm * BM + wr * 64 + fr; const int col0 = u.pn * HALF + wc * 32 + 8 * fq;
        float rsv[2][4]; get(ui, wr, fr, rsv);
#pragma unroll
        for (int ai = 0; ai < 2; ++ai)
#pragma unroll
            for (int m = 0; m < 4; ++m) { bf16_t* rowp = O + (size_t)(row0 + ai * HALF + m * 16) * ldc + col0; const float r = rsv[ai][m];
                const f32x4 g0 = acc[ai][0][m][0] * r, g1 = acc[ai][0][m][1] * r, u0 = acc[ai][1][m][0] * r, u1 = acc[ai][1][m][1] * r;
                u32x4 w; w.x = cvt_pk_bf16(silu_mul(g0[0], u0[0]), silu_mul(g0[1], u0[1])); w.y = cvt_pk_bf16(silu_mul(g0[2], u0[2]), silu_mul(g0[3], u0[3]));
                w.z = cvt_pk_bf16(silu_mul(g1[0], u1[0]), silu_mul(g1[1], u1[1])); w.w = cvt_pk_bf16(silu_mul(g1[2], u1[2]), silu_mul(g1[3], u1[3]));
                *(u32x4*)rowp = w; }
    }
};
__device__ __forceinline__ float bfl(unsigned w) { return __builtin_bit_cast(float, w << 16); }
__device__ __forceinline__ float bfh(unsigned w) { return __builtin_bit_cast(float, w & 0xffff0000u); }
struct EpiResid {
    static constexpr bool PERM = true, AFTER_DRAIN = false, ROWSCALE = false;
    bf16_t* hb; unsigned long long* ssq; int ldc; float s; PG8_LAS float* red;
    __device__ __forceinline__ void operator()(const f32x4 (&acc)[2][2][4][2], const Unit& u, int wr, int wc, int fr, int fq, int) const {
        const int row0 = u.pm * BM + wr * 64 + fr; const int col0 = u.pn * BM + wc * 32 + 8 * fq;
        u32x4 pre[8][2];
#pragma unroll
        for (int g = 0; g < 8; ++g) { const size_t off = (size_t)(row0 + (g >> 2) * HALF + (g & 3) * 16) * ldc + col0;
#pragma unroll
            for (int bj = 0; bj < 2; ++bj) pre[g][bj] = *(const u32x4*)(hb + off + bj * HALF); }
#pragma unroll
        for (int g = 0; g < 8; ++g) { const int ai = g >> 2, m = g & 3; const size_t off = (size_t)(row0 + ai * HALF + m * 16) * ldc + col0; float q = 0.f;
#pragma unroll
            for (int bj = 0; bj < 2; ++bj) { const u32x4 b = pre[g][bj];
                const f32x4 v0 = (f32x4){bfl(b.x), bfh(b.x), bfl(b.y), bfh(b.y)} + acc[ai][bj][m][0] * s, v1 = (f32x4){bfl(b.z), bfh(b.z), bfl(b.w), bfh(b.w)} + acc[ai][bj][m][1] * s;
                u32x4 w; w.x = cvt_pk_bf16(v0[0], v0[1]); w.y = cvt_pk_bf16(v0[2], v0[3]); w.z = cvt_pk_bf16(v1[0], v1[1]); w.w = cvt_pk_bf16(v1[2], v1[3]);
                *(u32x4*)(hb + off + bj * HALF) = w;
                q += (v0[0] * v0[0] + v0[1] * v0[1]) + (v0[2] * v0[2] + v0[3] * v0[3]) + (v1[0] * v1[0] + v1[1] * v1[1]) + (v1[2] * v1[2] + v1[3] * v1[3]); }
            { auto r16 = __builtin_amdgcn_permlane16_swap(__float_as_uint(q), __float_as_uint(q), false, false); q = __uint_as_float(r16[0]) + __uint_as_float(r16[1]);
              auto r32 = __builtin_amdgcn_permlane32_swap(__float_as_uint(q), __float_as_uint(q), false, false); q = __uint_as_float(r32[0]) + __uint_as_float(r32[1]); }
            if (fq == 0) red[wc * BM + ai * HALF + wr * 64 + m * 16 + fr] = q; }
        asm volatile("s_waitcnt lgkmcnt(0)" ::: "memory"); __builtin_amdgcn_s_barrier(); asm volatile("" ::: "memory");
        const int t = wr * 256 + wc * 64 + fq * 16 + fr;
        if (t < BM) { const float sum = (red[t] + red[BM + t]) + (red[2 * BM + t] + red[3 * BM + t]);
            (void)__hip_atomic_fetch_add(ssq + u.pm * BM + t, (unsigned long long)(sum * SSQ_FIX), __ATOMIC_RELAXED, __HIP_MEMORY_SCOPE_AGENT); }
        asm volatile("s_waitcnt lgkmcnt(0)" ::: "memory"); __builtin_amdgcn_s_barrier(); asm volatile("" ::: "memory");
    }
};
template <class Epi, class Sched, bool ALIGN_EPI = false, bool SP2 = false>
__device__ __forceinline__ void gemm_phase(PG8_LAS unsigned char* lds, const Gemm g, const Sched& S, const Epi& E) {
    const int tid = opaque_tid(), wid = __builtin_amdgcn_readfirstlane(tid >> 6), lane = tid & 63, wr = wid >> 2, wc = wid & 3, fr = lane & 15, fq = lane >> 4;
    const int K = g.K, nt = K / BK;
    unsigned voffA[2], voffB[2];
#pragma unroll
    for (int i = 0; i < 2; ++i) { int R, C; stage_rc(tid * 16 + i * 8192, R, C); const int Rb = Epi::PERM ? ((R & ~31) + perm32(R & 31)) : R;
        voffA[i] = (unsigned)(R * K + C) * 2u; voffB[i] = (unsigned)(Rb * K + C) * 2u; }
    const size_t kstep = (size_t)(BK * 2);
    const size_t hstep = (size_t)HALF * K * 2;
    const size_t tstep = 2 * hstep;
    const unsigned ldsw = (unsigned)wid * 1024u;
    const int aoff = lds_byte(wr * 64 + fr, fq * 8), boff = lds_byte(wc * 32 + fr, fq * 8);
#define PG8_SA(b, h) (((b) * 2 + (h)) * HTB)
#define PG8_SB(b, h) ((4 + (b) * 2 + (h)) * HTB)
#define PG8_STAGE(bufoff, gbase, voff) do { _Pragma("unroll") for (int _i = 0; _i < 2; ++_i) \
        __builtin_amdgcn_global_load_lds((const unsigned*)((const char*)(gbase) + (voff)[_i]), (PG8_LAS unsigned*)(lds + (bufoff) + ldsw + _i * 8192), 16, 0, 0); } while (0)
#define PG8_LDA(dst, b, h) do { _Pragma("unroll") for (int m = 0; m < 4; ++m) _Pragma("unroll") for (int k = 0; k < 2; ++k) dst[m][k] = *(const PG8_LAS bf16x8*)(lds + PG8_SA(b, h) + aoff + m * 2048 + k * 1024); } while (0)
#define PG8_LDB(dst, b, h) do { _Pragma("unroll") for (int n = 0; n < 2; ++n) _Pragma("unroll") for (int k = 0; k < 2; ++k) dst[n][k] = *(const PG8_LAS bf16x8*)(lds + PG8_SB(b, h) + boff + n * 2048 + k * 1024); } while (0)
#define PG8_MMA(ai, bj, At, Bt) do { __builtin_amdgcn_s_setprio(1); _Pragma("unroll") for (int m = 0; m < 4; ++m) _Pragma("unroll") for (int n = 0; n < 2; ++n) _Pragma("unroll") for (int k = 0; k < 2; ++k) \
        acc[ai][bj][m][n] = __builtin_amdgcn_mfma_f32_16x16x32_bf16(Bt[n][k], At[m][k], acc[ai][bj][m][n], 0, 0, 0); __builtin_amdgcn_s_setprio(0); } while (0)
#define PG8_WAIT_V(n) asm volatile("s_waitcnt vmcnt(" #n ")" ::: "memory")
#define PG8_WAIT_L(n) asm volatile("s_waitcnt lgkmcnt(" #n ")" ::: "memory")
#define PG8_BAR __builtin_amdgcn_s_barrier()
#define PG8_SCHED __builtin_amdgcn_sched_barrier(0)
    Unit cur, nxt; int ui = 0;
    if (!S.next(0, cur)) return;
    f32x4 acc[2][2][4][2];
#pragma unroll
    for (int a = 0; a < 2; ++a)
#pragma unroll
        for (int b = 0; b < 2; ++b)
#pragma unroll
            for (int m = 0; m < 4; ++m)
#pragma unroll
                for (int n = 0; n < 2; ++n) acc[a][b][m][n] = (f32x4){0.f, 0.f, 0.f, 0.f};
    bf16x8 At[4][2], B0[2][2], B1[2][2];
    const char* cA = S.aptr(g, cur, tstep); const char* cB = S.bptr(g, cur, tstep);
    S.a_ready(cur);
    if constexpr (Epi::ROWSCALE) E.rs_store(E.rs_load(cur.pm, tid), 0, tid);
    if constexpr (SP2) {
        PG8_STAGE(PG8_SB(0, 0), cB, voffB); PG8_STAGE(PG8_SB(0, 1), cB + hstep, voffB); PG8_STAGE(PG8_SA(0, 0), cA, voffA); PG8_STAGE(PG8_SA(0, 1), cA + hstep, voffA);
        if (wr == 1) PG8_BAR;
        PG8_WAIT_V(2); PG8_BAR;
        PG8_STAGE(PG8_SB(1, 0), cB + kstep, voffB); PG8_STAGE(PG8_SA(1, 0), cA + kstep, voffA); PG8_STAGE(PG8_SB(1, 1), cB + hstep + kstep, voffB);
        PG8_WAIT_V(6); PG8_BAR;
    } else {
        PG8_STAGE(PG8_SB(0, 0), cB, voffB); PG8_STAGE(PG8_SA(0, 0), cA, voffA); PG8_STAGE(PG8_SB(0, 1), cB + hstep, voffB); PG8_STAGE(PG8_SA(0, 1), cA + hstep, voffA);
        if (wr == 1) PG8_BAR;
        PG8_WAIT_V(4); PG8_BAR;
        PG8_STAGE(PG8_SB(1, 0), cB + kstep, voffB); PG8_STAGE(PG8_SA(1, 0), cA + kstep, voffA); PG8_STAGE(PG8_SB(1, 1), cB + hstep + kstep, voffB);
        PG8_WAIT_V(6); PG8_BAR;
    }
    for (;;) {
        const bool has_next = S.next(ui + 1, nxt);
        const char* nA = has_next ? S.aptr(g, nxt, tstep) : cA; const char* nB = has_next ? S.bptr(g, nxt, tstep) : cB;
        for (int t = 0; t < nt; t += 2) {
            const bool last = (t == nt - 2);
            const char* a1 = cA + (size_t)(t + 1) * kstep;
            const char* a2 = last ? nA : cA + (size_t)(t + 2) * kstep; const char* b2 = last ? nB : cB + (size_t)(t + 2) * kstep;
            const char* a3 = a2 + kstep; const char* b3 = b2 + kstep;
            if (last && has_next) S.a_ready(nxt);
            if constexpr (SP2) {
            PG8_LDB(B0, 0, 0); PG8_LDB(B1, 0, 1); PG8_SCHED; PG8_LDA(At, 0, 0); PG8_STAGE(PG8_SA(1, 1), a1 + hstep, voffA);
            PG8_WAIT_V(8); PG8_WAIT_L(0); PG8_BAR; PG8_MMA(0, 0, At, B0); PG8_MMA(0, 1, At, B1); PG8_BAR; PG8_SCHED;
            PG8_LDA(At, 0, 1); PG8_STAGE(PG8_SB(0, 0), b2, voffB); PG8_STAGE(PG8_SB(0, 1), b2 + hstep, voffB); PG8_STAGE(PG8_SA(0, 0), a2, voffA);
            PG8_WAIT_V(8); PG8_WAIT_L(0); PG8_BAR; PG8_MMA(1, 0, At, B0); PG8_MMA(1, 1, At, B1); PG8_BAR; PG8_SCHED;
            PG8_LDB(B0, 1, 0); PG8_LDB(B1, 1, 1); PG8_SCHED; PG8_LDA(At, 1, 0); PG8_STAGE(PG8_SA(0, 1), a2 + hstep, voffA);
            PG8_WAIT_V(8); PG8_WAIT_L(0); PG8_BAR; PG8_MMA(0, 0, At, B0); PG8_MMA(0, 1, At, B1); PG8_BAR; PG8_SCHED;
            PG8_LDA(At, 1, 1); PG8_STAGE(PG8_SB(1, 0), b3, voffB); PG8_STAGE(PG8_SB(1, 1), b3 + hstep, voffB); PG8_STAGE(PG8_SA(1, 0), a3, voffA);
            PG8_WAIT_V(8); PG8_WAIT_L(0); PG8_BAR; PG8_MMA(1, 0, At, B0); PG8_MMA(1, 1, At, B1); PG8_BAR; PG8_SCHED;
            } else {
            PG8_LDB(B0, 0, 0); PG8_SCHED; PG8_LDA(At, 0, 0); PG8_STAGE(PG8_SA(1, 1), a1 + hstep, voffA);
            PG8_WAIT_L(8); PG8_BAR; PG8_WAIT_L(0); PG8_MMA(0, 0, At, B0); PG8_BAR; PG8_SCHED;
            PG8_LDB(B1, 0, 1); PG8_STAGE(PG8_SB(0, 0), b2, voffB);
            PG8_BAR; PG8_WAIT_L(0); PG8_MMA(0, 1, At, B1); PG8_BAR;
            PG8_LDA(At, 0, 1); PG8_STAGE(PG8_SA(0, 0), a2, voffA);
            PG8_BAR; PG8_WAIT_L(0); PG8_MMA(1, 0, At, B0); PG8_BAR; PG8_SCHED;
            PG8_STAGE(PG8_SB(0, 1), b2 + hstep, voffB);
            PG8_WAIT_V(6); PG8_BAR; PG8_MMA(1, 1, At, B1); PG8_BAR;
            PG8_LDB(B0, 1, 0); PG8_SCHED; PG8_LDA(At, 1, 0); PG8_STAGE(PG8_SA(0, 1), a2 + hstep, voffA);
            PG8_WAIT_L(8); PG8_BAR; PG8_WAIT_L(0); PG8_MMA(0, 0, At, B0); PG8_BAR; PG8_SCHED;
            PG8_LDB(B1, 1, 1); PG8_STAGE(PG8_SB(1, 0), b3, voffB);
            PG8_BAR; PG8_WAIT_L(0); PG8_MMA(0, 1, At, B1); PG8_BAR;
            PG8_LDA(At, 1, 1); PG8_STAGE(PG8_SA(1, 0), a3, voffA);
            PG8_BAR; PG8_WAIT_L(0); PG8_MMA(1, 0, At, B0); PG8_BAR; PG8_SCHED;
            PG8_STAGE(PG8_SB(1, 1), b3 + hstep, voffB);
            PG8_WAIT_V(6); PG8_BAR; PG8_MMA(1, 1, At, B1); PG8_BAR;
            }
        }
        if constexpr (ALIGN_EPI) { if (wr == 0) PG8_BAR; }
        if constexpr (!Epi::AFTER_DRAIN) {
            unsigned long long pend_ = 0ull; if constexpr (Epi::ROWSCALE) pend_ = E.rs_load(has_next ? nxt.pm : cur.pm, tid);
            E(acc, cur, wr, wc, fr, fq, ui);
            if constexpr (Epi::ROWSCALE) E.rs_store(pend_, ui + 1, tid);
            S.done(cur); }
        if (!has_next) break;
#pragma unroll
        for (int a = 0; a < 2; ++a)
#pragma unroll
            for (int b = 0; b < 2; ++b)
#pragma unroll
                for (int m = 0; m < 4; ++m)
#pragma unroll
                    for (int n = 0; n < 2; ++n) acc[a][b][m][n] = (f32x4){0.f, 0.f, 0.f, 0.f};
        cur = nxt; cA = nA; cB = nB; ++ui;
        if constexpr (ALIGN_EPI) { if (wr == 1) PG8_BAR; }
    }
    PG8_WAIT_V(0);
    if constexpr (!ALIGN_EPI) { if (wr == 0) PG8_BAR; }
    PG8_BAR;
    if constexpr (Epi::AFTER_DRAIN) { E.fused(acc, cur, wr, wc, fr, fq, lds, wid, lane); S.done(cur); }
#undef PG8_SA
#undef PG8_SB
#undef PG8_STAGE
#undef PG8_LDA
#undef PG8_LDB
#undef PG8_MMA
#undef PG8_WAIT_V
#undef PG8_WAIT_L
#undef PG8_BAR
#undef PG8_SCHED
}
}

namespace at {
#define AT_LAS __attribute__((address_space(3)))
typedef unsigned short bf16_t;
typedef short bf16x8 __attribute__((ext_vector_type(8)));
typedef short s16x4 __attribute__((ext_vector_type(4)));
typedef float f32x16 __attribute__((ext_vector_type(16)));
typedef float f32x4 __attribute__((ext_vector_type(4)));
typedef unsigned u32x4 __attribute__((ext_vector_type(4)));
constexpr int KVBLK = 64, SHM_V = 16384, SHM_K = 16384;
constexpr int OFF_V = 0, OFF_K = 2 * SHM_V, OFF_BIAS = OFF_K + 2 * SHM_K, OFF_WS = OFF_BIAS + 1024  , OFF_Q = OFF_WS + 8 * 256, OFF_X = 0  , ATT_LDS = OFF_Q + 256;
static_assert(4 * 32 * 128 * 4 <= OFF_BIAS, "exchange fits the tile buffers");
constexpr float THR = 8.f;
#ifdef PROBE_DUP
constexpr bool AT_PROBE_MFMA2 = (PROBE_DUP & 1024) != 0, AT_PROBE_VALU = (PROBE_DUP & 2048) != 0, AT_PROBE_BAR = (PROBE_DUP & 32768) != 0;
#else
constexpr bool AT_PROBE_MFMA2 = false, AT_PROBE_VALU = false, AT_PROBE_BAR = false;
#endif

#define KSWZ(row, colB) ((row) * 256 + ((colB) ^ (((row) & 7) << 4)))
#define SBAR() __builtin_amdgcn_sched_barrier(0)
__device__ __forceinline__ int v_st(int k, int c) { const int kk = (k & ~0xC) | ((k & 4) << 1) | ((k & 8) >> 1); return ((kk >> 3) * 4 + (c >> 5)) * 512 + ((kk & 7) * 32 + (c & 31)) * 2; }
__device__ __forceinline__ int v_rd_base(int lane) { return ((lane & 3) << 3) | (((lane >> 2) & 3) << 6) | (((lane >> 4) & 1) << 5) | (((lane >> 5) & 1) << 8); }
constexpr int v_rd_off(int d0, int ks, int half) { return d0 * 512 + ks * 4096 + half * 2048; }
__device__ __forceinline__ int crow(int r, int hi) { return (r & 3) + 8 * (r >> 2) + 4 * hi; }
__device__ __forceinline__ unsigned cvtpk(float lo, float hi) { unsigned r; asm volatile("v_cvt_pk_bf16_f32 %0, %1, %2" : "=v"(r) : "v"(lo), "v"(hi)); return r; }

template <int CTRL> __device__ __forceinline__ float dppf(float v) { return __builtin_bit_cast(float, __builtin_amdgcn_update_dpp(0, __builtin_bit_cast(int, v), CTRL, 0xF, 0xF, true)); }
__device__ __forceinline__ float lane_xor1(float v) { return dppf<0xB1>(v); }
__device__ __forceinline__ float sum32(float s) {
    s += dppf<0xB1>(s); s += dppf<0x4E>(s);
    s += dppf<0x141>(s); s += dppf<0x140>(s);
    s += __shfl_xor(s, 16); return s; }
template <int CTRL, int RMASK> __device__ __forceinline__ float dpp0(float v) { return __builtin_bit_cast(float, __builtin_amdgcn_update_dpp(0, __builtin_bit_cast(int, v), CTRL, RMASK, 0xF, false)); }
__device__ __forceinline__ float wave_incl_scan(float x) {
    x += dpp0<0x111, 0xF>(x); x += dpp0<0x112, 0xF>(x); x += dpp0<0x114, 0xF>(x); x += dpp0<0x118, 0xF>(x);
    x += dpp0<0x142, 0xA>(x);
    x += dpp0<0x143, 0xC>(x);
    return x;
}
__device__ __forceinline__ void mask_tile(f32x16& p0, f32x16& p1, int dq, unsigned W) {
    const float NEG = -__builtin_inff();
#pragma unroll
    for (int r = 0; r < 16; ++r) {
        const int c = (r & 3) + 8 * (r >> 2);
        if ((unsigned)(dq - c) >= W) p0[r] = NEG;
        if ((unsigned)(dq - c - 32) >= W) p1[r] = NEG;
    }
}
template <int SCI> struct ScaleOf { static constexpr float v = SCI == 64 ? 0.125f : 0.08838834764831845f; };
template <int SCI>
__device__ __forceinline__ void partialSM(f32x16& p0, f32x16& p1, float& m_reg, float& mn, float& alpha) {
    constexpr float SCALE = ScaleOf<SCI>::v;
    float pmax = p0[0];
#pragma unroll
    for (int r = 1; r < 16; ++r) pmax = fmaxf(pmax, p0[r]);
#pragma unroll
    for (int r = 0; r < 16; ++r) pmax = fmaxf(pmax, p1[r]);
    { auto rr = __builtin_amdgcn_permlane32_swap(__float_as_uint(pmax), __float_as_uint(pmax), false, false);
      pmax = fmaxf(__uint_as_float(rr[0]), __uint_as_float(rr[1])); }
    constexpr float C2 = 1.4426950408889634f * SCALE;
    if (__builtin_expect(__all((pmax - m_reg) * SCALE <= THR), 1)) { mn = m_reg; alpha = 1.f; }
    else { mn = fmaxf(m_reg, pmax); alpha = __builtin_amdgcn_exp2f((m_reg - mn) * C2); m_reg = mn; }
    const float mnL = -mn * C2;
#pragma unroll
    for (int r = 0; r < 16; ++r) p0[r] = fmaf(p0[r], C2, mnL);
#pragma unroll
    for (int r = 0; r < 16; ++r) p1[r] = fmaf(p1[r], C2, mnL);
#pragma unroll
    for (int r = 0; r < 16; ++r) p0[r] = __builtin_amdgcn_exp2f(p0[r]);
}
__device__ __forceinline__ void finishSM(f32x16& p0, f32x16& p1, float alpha, float& l_reg, bf16x8& pa0, bf16x8& pa1, bf16x8& pa2, bf16x8& pa3) {
#pragma unroll
    for (int r = 0; r < 16; ++r) p1[r] = __builtin_amdgcn_exp2f(p1[r]);
    float ps = 0;
#pragma unroll
    for (int r = 0; r < 16; ++r) ps += p0[r];
#pragma unroll
    for (int r = 0; r < 16; ++r) ps += p1[r];
    { auto rr = __builtin_amdgcn_permlane32_swap(__float_as_uint(ps), __float_as_uint(ps), false, false);
      ps = __uint_as_float(rr[0]) + __uint_as_float(rr[1]); }
    l_reg = l_reg * alpha + ps;
#define PK4(P, B_, OUT) do { unsigned a0 = cvtpk(P[B_+0], P[B_+1]), a1 = cvtpk(P[B_+2], P[B_+3]);                          \
        unsigned b0 = cvtpk(P[B_+4], P[B_+5]), b1 = cvtpk(P[B_+6], P[B_+7]);                                             \
        auto r0 = __builtin_amdgcn_permlane32_swap(a0, b0, false, false); auto r1 = __builtin_amdgcn_permlane32_swap(a1, b1, false, false); \
        u32x4 w = {r0[0], r1[0], r0[1], r1[1]}; OUT = *reinterpret_cast<bf16x8*>(&w); } while (0)
    PK4(p0, 0, pa0); PK4(p0, 8, pa1); PK4(p1, 0, pa2); PK4(p1, 8, pa3);
#undef PK4
}
template <int NK, int KB>
__device__ __forceinline__ void qkt(f32x16& p0, f32x16& p1, const AT_LAS char* K_lds, int r32, int hi, const bf16x8* qr) {
    p0 = f32x16{}; p1 = f32x16{};
    const AT_LAS char* kb[4];
#pragma unroll
    for (int dd = 0; dd < 4; ++dd) kb[dd] = K_lds + KB * SHM_K + KSWZ(r32, (dd * 16 + hi * 8) * 2);
#pragma unroll
    for (int d0 = 0; d0 < NK; ++d0) { const AT_LAS char* a = kb[d0 & 3] + (d0 >> 2) * 128;
        const bf16x8 b0 = *reinterpret_cast<const AT_LAS bf16x8*>(a);
        const bf16x8 b1 = *reinterpret_cast<const AT_LAS bf16x8*>(a + 32 * 256);
        p0 = __builtin_amdgcn_mfma_f32_32x32x16_bf16(b0, qr[d0], p0, 0, 0, 0);
        p1 = __builtin_amdgcn_mfma_f32_32x32x16_bf16(b1, qr[d0], p1, 0, 0, 0); }
}
template <int D0, int KB>
__device__ __forceinline__ void qkt_load4(bf16x8 (&kf)[8], const AT_LAS char* K_lds, int r32, int hi) {
#pragma unroll
    for (int dd = 0; dd < 4; ++dd) { const AT_LAS char* a = K_lds + KB * SHM_K + KSWZ(r32, (dd * 16 + hi * 8) * 2) + (D0 >> 2) * 128;
        kf[2 * dd] = *reinterpret_cast<const AT_LAS bf16x8*>(a); kf[2 * dd + 1] = *reinterpret_cast<const AT_LAS bf16x8*>(a + 32 * 256); }
}
template <int D0>
__device__ __forceinline__ void qkt_mfma4(f32x16& p0, f32x16& p1, const bf16x8 (&kf)[8], const bf16x8* qr) {
#pragma unroll
    for (int dd = 0; dd < 4; ++dd) {
        p0 = __builtin_amdgcn_mfma_f32_32x32x16_bf16(kf[2 * dd], qr[D0 + dd], p0, 0, 0, 0);
        p1 = __builtin_amdgcn_mfma_f32_32x32x16_bf16(kf[2 * dd + 1], qr[D0 + dd], p1, 0, 0, 0); }
}
template <int VB>
__device__ __forceinline__ void pv_tile(f32x16* o, int vb0, bf16x8 pa0, bf16x8 pa1, bf16x8 pa2, bf16x8 pa3) {
#define TRRD(dst, off) asm volatile("ds_read_b64_tr_b16 %0, %1 offset:%2" : "=&v"(dst) : "v"(vb0), "i"(off) : "memory")
#define PV_D0(d0) do { s16x4 l0, l1, l2, l3, h0, h1, h2, h3; constexpr int b_ = VB * SHM_V + v_rd_off(d0, 0, 0);     \
        TRRD(l0, b_); TRRD(h0, b_ + 2048); TRRD(l1, b_ + 4096); TRRD(h1, b_ + 6144); TRRD(l2, b_ + 8192); TRRD(h2, b_ + 10240); TRRD(l3, b_ + 12288); TRRD(h3, b_ + 14336); \
        asm volatile("s_waitcnt lgkmcnt(0)" ::: "memory"); SBAR();                                                                                   \
        o[d0] = __builtin_amdgcn_mfma_f32_32x32x16_bf16(pa0, (bf16x8){l0[0], l0[1], l0[2], l0[3], h0[0], h0[1], h0[2], h0[3]}, o[d0], 0, 0, 0);   \
        o[d0] = __builtin_amdgcn_mfma_f32_32x32x16_bf16(pa1, (bf16x8){l1[0], l1[1], l1[2], l1[3], h1[0], h1[1], h1[2], h1[3]}, o[d0], 0, 0, 0);   \
        o[d0] = __builtin_amdgcn_mfma_f32_32x32x16_bf16(pa2, (bf16x8){l2[0], l2[1], l2[2], l2[3], h2[0], h2[1], h2[2], h2[3]}, o[d0], 0, 0, 0);   \
        o[d0] = __builtin_amdgcn_mfma_f32_32x32x16_bf16(pa3, (bf16x8){l3[0], l3[1], l3[2], l3[3], h3[0], h3[1], h3[2], h3[3]}, o[d0], 0, 0, 0); } while (0)
    PV_D0(0); PV_D0(1); PV_D0(2); PV_D0(3);
#undef PV_D0
#undef TRRD
}

template <int MODE>
__device__ __forceinline__ void attn_unit(AT_LAS char* lds, const bf16_t* Qp, int qpitch, const bf16_t* Kp, const bf16_t* Vp, int kvpitch, const float* cb, int q0, int NT,
                                          bf16_t* Op, int opitch, float lam, const float* subg, float outscale, unsigned* qhead, unsigned& qpre) {
    constexpr int NK = (MODE == 1) ? 4 : 8, SCI = (MODE == 1) ? 64 : 128;
    const int tid = opaque_tid(), wid = __builtin_amdgcn_readfirstlane(tid >> 6), lane = tid & 63, r32 = lane & 31, hi = lane >> 5;
    const int comp = (MODE == 1) ? (wid >> 2) : 0;
    const int wrow = (MODE == 1) ? (wid & 3) * 32 : wid * 32;
    bf16x8 qr[NK];
    { const bf16_t* qrow = Qp + (size_t)(wrow + r32) * qpitch + comp * 64 + hi * 8;
#pragma unroll
      for (int d0 = 0; d0 < NK; ++d0) qr[d0] = *reinterpret_cast<const bf16x8*>(qrow + d0 * 16); }
    AT_LAS char* V_lds = lds + OFF_V; AT_LAS char* K_lds = lds + OFF_K; AT_LAS float* bias_l = (AT_LAS float*)(lds + OFF_BIAS);
    AT_LAS float* ws = (AT_LAS float*)(lds + OFF_WS) + wid * 64; AT_LAS float* li_l = ws; AT_LAS float* al_l = ws + 32;
    const int sr = tid >> 4, sc = (tid & 15) * 8;
    const int vst0 = v_st(sr, sc), vst1 = v_st(32 + sr, sc), kws = KSWZ(sr, sc * 2);
    const int vb0 = (int)(unsigned)(uintptr_t)V_lds + v_rd_base(lane);
    const AT_LAS char* Kq = K_lds + comp * 128;
    const int qlo = q0 + wrow, qm = qlo + r32 - 4 * hi;
    float m_reg = -1e30f, l_reg = 0.f; f32x16 o[4];
#pragma unroll
    for (int d = 0; d < 4; ++d) o[d] = f32x16{};
    bf16x8 st_k0, st_k1, st_v0, st_v1; float st_b = 0.f, carry = 0.f;
    constexpr float BSC = -11.313708498984761f;
#define AT_SLOAD(i) do { if ((i) + 2 < NT) { const size_t r0_ = (size_t)(((i) + 2) * KVBLK + sr) * kvpitch + sc, r1_ = r0_ + (size_t)32 * kvpitch;              \
            st_k0 = *reinterpret_cast<const bf16x8*>(Kp + r0_); st_k1 = *reinterpret_cast<const bf16x8*>(Kp + r1_);                                     \
            if (MODE == 0) { if (tid < 64) st_b = cb[((i) + 2) * KVBLK + tid]; } }                                                                      \
        if ((i) + 1 < NT) { const size_t r0_ = (size_t)(((i) + 1) * KVBLK + sr) * kvpitch + sc, r1_ = r0_ + (size_t)32 * kvpitch;                      \
            st_v0 = *reinterpret_cast<const bf16x8*>(Vp + r0_); st_v1 = *reinterpret_cast<const bf16x8*>(Vp + r1_); } } while (0)
#define AT_SWRITE(i, KB  ) do {                                                                                                           \
        if ((i) + 1 < NT) { *reinterpret_cast<AT_LAS bf16x8*>(K_lds + (1 - (KB)) * SHM_K + kws) = st_k0; *reinterpret_cast<AT_LAS bf16x8*>(K_lds + (1 - (KB)) * SHM_K + kws + 32 * 256) = st_k1; \
            if (MODE == 0) { if (tid < 64) { const float c_ = carry + wave_incl_scan(st_b); bias_l[(((i) + 1) & 3) * 64 + tid] = c_ * BSC; carry = __builtin_bit_cast(float, __builtin_amdgcn_readlane(__builtin_bit_cast(int, c_), 63)); } } }   \
        if ((i) < NT) { *reinterpret_cast<AT_LAS bf16x8*>(V_lds + (KB) * SHM_V + vst0) = st_v0; *reinterpret_cast<AT_LAS bf16x8*>(V_lds + (KB) * SHM_V + vst1) = st_v1; } } while (0)
#define AT_RESC(a) do { if (__any((a) < 1.f)) { if (hi == 0) al_l[r32] = (a); asm volatile("s_waitcnt lgkmcnt(0)" ::: "memory");                        \
        _Pragma("unroll") for (int d_ = 0; d_ < 4; ++d_) _Pragma("unroll") for (int r = 0; r < 16; ++r) o[d_][r] *= al_l[crow(r, hi)]; } } while (0)
#define AT_ITER(i, KB) do {                                                                                                                              \
        AT_SWRITE(i, KB); AT_SLOAD(i); SBAR();                                                                                                          \
        if ((i) < NT) { qkt_load4<0, KB>(kf, Kq, r32, hi); SBAR(); }         \
        if ((i) >= 1) pv_tile<1 - (KB)>(o, vb0, pa0, pa1, pa2, pa3);                                                                                    \
        if ((i) < NT) { SBAR(); p0 = f32x16{}; p1 = f32x16{}; qkt_mfma4<0>(p0, p1, kf, qr);                                                             \
            if (NK == 8) { qkt_load4<4, KB>(kf, Kq, r32, hi); qkt_mfma4<(NK == 8 ? 4 : 0)>(p0, p1, kf, qr); } }                                         \
        if (AT_PROBE_MFMA2) { if ((i) < NT) { asm volatile("" : "+v"(p0), "+v"(p1));     \
            qkt_load4<0, KB>(kf, Kq, r32, hi); p0 = f32x16{}; p1 = f32x16{}; qkt_mfma4<0>(p0, p1, kf, qr);                                             \
            if (NK == 8) { qkt_load4<4, KB>(kf, Kq, r32, hi); qkt_mfma4<(NK == 8 ? 4 : 0)>(p0, p1, kf, qr); } } }                                       \
        SBAR(); __syncthreads();                                                                                                                        \
        if ((i) < NT) {                                                                                                                                 \
            if (MODE == 0) { const AT_LAS float* bl = bias_l + ((i) & 3) * 64 + 4 * hi;                                                                \
                _Pragma("unroll") for (int g = 0; g < 4; ++g) { const f32x4 b0_ = *reinterpret_cast<const AT_LAS f32x4*>(bl + 8 * g), b1_ = *reinterpret_cast<const AT_LAS f32x4*>(bl + 32 + 8 * g); \
                    _Pragma("unroll") for (int e = 0; e < 4; ++e) { p0[4 * g + e] += b0_[e]; p1[4 * g + e] += b1_[e]; } } }                          \
            if (MODE != 2) { const int kb_ = (i) * KVBLK; if (kb_ + KVBLK - 1 > qlo) mask_tile(p0, p1, qm - kb_, 0x7fffffffu); }                       \
            if (AT_PROBE_VALU) { float dm_ = 0.f; _Pragma("unroll") for (int q_ = 0; q_ < 128; ++q_) asm volatile("v_add_f32 %0, %0, %0" : "+v"(dm_)); }     \
            float mn_, al_; partialSM<SCI>(p0, p1, m_reg, mn_, al_);                                                                                   \
            finishSM(p0, p1, al_, l_reg, pa0, pa1, pa2, pa3);                                                                                           \
            AT_RESC(al_); }                                                                                                                             \
        SBAR(); __syncthreads(); if (AT_PROBE_BAR) { __syncthreads(); __syncthreads(); } } while (0)
#ifndef AT_GRP_BY_PARITY
#define AT_GRP_BY_PARITY 0
#endif
    const bool grpA = AT_GRP_BY_PARITY ? (wid & 1) == 0 : wid < 4;
    f32x16 p0, p1; bf16x8 pa0, pa1, pa2, pa3; bf16x8 kf[8];
    { const size_t r0_ = (size_t)sr * kvpitch + sc, r1_ = r0_ + (size_t)32 * kvpitch;
      st_k0 = *reinterpret_cast<const bf16x8*>(Kp + r0_); st_k1 = *reinterpret_cast<const bf16x8*>(Kp + r1_);
      if (MODE == 0) { if (tid < 64) st_b = cb[tid]; }
      asm volatile("s_waitcnt vmcnt(0)" ::: "memory");
      *reinterpret_cast<AT_LAS bf16x8*>(K_lds + kws) = st_k0; *reinterpret_cast<AT_LAS bf16x8*>(K_lds + kws + 32 * 256) = st_k1;
      if (MODE == 0) { if (tid < 64) { const float c_ = wave_incl_scan(st_b); bias_l[tid] = c_ * BSC; carry = __builtin_bit_cast(float, __builtin_amdgcn_readlane(__builtin_bit_cast(int, c_), 63)); } } }
    AT_SLOAD(-1);
    __syncthreads();
    if (!grpA) __syncthreads();
    for (int i = 0; i < NT; i += 2) { AT_ITER(i, 0); AT_ITER(i + 1, 1); }
    if (qhead != nullptr) { if (tid == 0) qpre = __hip_atomic_fetch_add(qhead, 1u, __ATOMIC_RELAXED, __HIP_MEMORY_SCOPE_AGENT); }
    AT_ITER(NT, 0);
    if (grpA) __syncthreads();
#undef AT_ITER
#undef AT_RESC
#undef AT_SWRITE
#undef AT_SLOAD
    if (hi == 0) li_l[r32] = l_reg;
    asm volatile("s_waitcnt lgkmcnt(0)" ::: "memory");
    float rli[16];
#pragma unroll
    for (int r = 0; r < 16; ++r) rli[r] = __builtin_amdgcn_rcpf(li_l[crow(r, hi)]);
    bf16_t* Ow = Op + (size_t)wrow * opitch;
    if (MODE != 1) {
#pragma unroll
        for (int r = 0; r < 16; ++r) { const int orow = crow(r, hi);
#pragma unroll
            for (int d0 = 0; d0 < 4; ++d0) { const float v = o[d0][r] * rli[r]; const float vn = lane_xor1(v);
                if ((r32 & 1) == 0) *(unsigned*)(Ow + (size_t)orow * opitch + d0 * 32 + r32) = cvtpk(v, vn); } }
        __syncthreads();
    } else {
        AT_LAS float* X = (AT_LAS float*)(lds + OFF_X) + (wid & 3) * 4096;
        if (comp == 1) {
#pragma unroll
            for (int r = 0; r < 16; ++r)
#pragma unroll
                for (int d0 = 0; d0 < 4; ++d0) X[crow(r, hi) * 128 + d0 * 32 + r32] = o[d0][r] * rli[r];
        }
        __syncthreads();
        if (comp == 0) {
            float g[4];
#pragma unroll
            for (int d0 = 0; d0 < 4; ++d0) g[d0] = subg[d0 * 32 + r32] * outscale;
#pragma unroll
            for (int r = 0; r < 16; ++r) { const int orow = crow(r, hi); float dv[4]; float s = 0.f;
#pragma unroll
                for (int d0 = 0; d0 < 4; ++d0) { dv[d0] = o[d0][r] * rli[r] - lam * X[orow * 128 + d0 * 32 + r32]; s += dv[d0] * dv[d0]; }
                s = sum32(s);
                const float rms = 1.0f / sqrtf(s * (1.0f / 128.0f) + 1e-6f);
#pragma unroll
                for (int d0 = 0; d0 < 4; ++d0) { const float v = dv[d0] * rms * g[d0]; const float vn = lane_xor1(v);
                    if ((r32 & 1) == 0) *(unsigned*)(Ow + (size_t)orow * opitch + d0 * 32 + r32) = cvtpk(v, vn); } }
        }
        __syncthreads();
    }
}
#undef SBAR
}

constexpr int D = 2048, BATCH = 4, SEQ = 4096, M = BATCH * SEQ, DEPTH = 4, MEMLEN = 256, MMEM = BATCH * MEMLEN;
constexpr int FF = 5632, NGU = 2 * FF, INW = 6150, INP = 6144, CRW = 512, NFH = 6;
constexpr int C_FQ = 0, C_FK = 768, C_FV = 1536, C_DQ = 2304, C_DK = 3072, C_DV = 3840, C_GB = 4608, C_GC = 5120, C_HC = 5632;
constexpr float EPS = 1e-6f;
constexpr int NWAVES = 8, NTHR = 512;
constexpr size_t MiB = 1u << 20;
constexpr size_t WS_CTL = 0, CTL_ZERO_BYTES = 4 * MiB;
constexpr size_t LW_GU1 = 0, LW_D1 = 44 * MiB, LW_GU2 = 66 * MiB, LW_D2 = 110 * MiB, LW_IN = 132 * MiB, LW_OUT = 156 * MiB, LW_Q = 164 * MiB, LW_KV = 166 * MiB, LW_O = 170 * MiB, LW_SIZE = 172 * MiB;
constexpr size_t WS_SSQ = 1 * MiB;
constexpr size_t WS_W = 4 * MiB;
constexpr size_t WS_NB = WS_W + DEPTH * LW_SIZE;
constexpr size_t WS_ACT = WS_NB + 64 * MiB;
constexpr size_t WS_PROJ = WS_ACT + 176 * MiB;
constexpr size_t WS_MIX = WS_PROJ + 192 * MiB;
constexpr size_t WS_QC = WS_MIX + 64 * MiB;
constexpr size_t WS_OC = WS_QC + 16 * MiB;
constexpr size_t WS_KV = WS_OC + 16 * MiB;
constexpr size_t WS_MEMN = WS_KV + 8 * MiB;
constexpr size_t WS_LOGF = WS_MEMN + 16 * MiB;
constexpr size_t WS_CUM = WS_LOGF + 1 * MiB;
constexpr size_t WS_ROPE = WS_CUM + 1 * MiB;
constexpr size_t WS_WFF = WS_ROPE + 1 * MiB;
constexpr size_t WS_END = WS_WFF + 1 * MiB;
static_assert(WS_SSQ + 18 * (size_t)M * 8 <= CTL_ZERO_BYTES, "ssq accumulators inside the memset region");
static_assert((size_t)NGU * D * 2 == 44 * MiB && (size_t)D * FF * 2 == 22 * MiB && (size_t)INP * D * 2 == 24 * MiB && (size_t)M * FF * 2 == 176 * MiB && (size_t)M * INP * 2 == 192 * MiB, "ws map");
constexpr int CW_BAR = 4096;
constexpr int CW_BIN = 8192;
constexpr int CW_GRP = 9216, CW_GXCC = 14336;
constexpr int CW_QUEUE = 16384;
constexpr int RING_OFF = 0, RING_BYTES = 131072;
constexpr int LDSCTL_OFF = RING_BYTES, MISC_OFF = LDSCTL_OFF + 320, RED_OFF = LDSCTL_OFF + 1024, RSC_OFF = LDSCTL_OFF + 5120;
constexpr int LDS_BYTES = 147456;
static_assert(at::ATT_LDS <= RING_BYTES, "attention scratch fits the ring region");

#define GAS __attribute__((address_space(1)))
#define LAS __attribute__((address_space(3)))
typedef unsigned short bf16;
typedef unsigned v4u __attribute__((ext_vector_type(4)));
typedef unsigned v2u __attribute__((ext_vector_type(2)));
typedef float f32x4 __attribute__((ext_vector_type(4)));
typedef float f32x2 __attribute__((ext_vector_type(2)));
typedef short bf16x8 __attribute__((ext_vector_type(8)));
typedef GAS unsigned gu32;
#define RLX_AGENT __ATOMIC_RELAXED, __HIP_MEMORY_SCOPE_AGENT
#define LDS_WAIT() asm volatile("s_waitcnt lgkmcnt(0)" ::: "memory")
#define VM_WAIT() asm volatile("s_waitcnt vmcnt(0)" ::: "memory")
__device__ __forceinline__ unsigned f2bf(float f) { unsigned u = __builtin_bit_cast(unsigned, f); return (u + 0x7fffu + ((u >> 16) & 1u)) >> 16; }
__device__ __forceinline__ unsigned pk2(float lo, float hi) { return f2bf(lo) | (f2bf(hi) << 16); }
__device__ __forceinline__ float bf_lo(unsigned w) { return __builtin_bit_cast(float, w << 16); }
__device__ __forceinline__ float bf_hi(unsigned w) { return __builtin_bit_cast(float, w & 0xffff0000u); }
template <int CTRL> __device__ __forceinline__ float dpp_f(float v) { return __builtin_bit_cast(float, __builtin_amdgcn_update_dpp(0, __builtin_bit_cast(int, v), CTRL, 0xF, 0xF, true)); }
__device__ __forceinline__ float wave_sum(float v) {
    v += dpp_f<0xB1>(v); v += dpp_f<0x4E>(v);
    v += dpp_f<0x141>(v); v += dpp_f<0x140>(v);
    v += __shfl_xor(v, 16);
    { auto rr = __builtin_amdgcn_permlane32_swap(__float_as_uint(v), __float_as_uint(v), false, false);
      v = __uint_as_float(rr[0]) + __uint_as_float(rr[1]); }
    return v;
}
#define XB_TMO      128
#define XB_XCNT(j)  (256  + 64 * (j))
#define XB_XSUB(j)  (1280 + 64 * (j))
#define XB_XGEN(j)  (2304 + 64 * (j))
#define XB_TOP      3328
#define XB_TOPGEN   3392
#define XCD_BAR_WORDS 3456
#define XB_SPIN_CAP (1u << 18)

__device__ __forceinline__ unsigned xb_ld(unsigned* p)              { return __hip_atomic_load(p, __ATOMIC_RELAXED, __HIP_MEMORY_SCOPE_AGENT); }
__device__ __forceinline__ unsigned xb_add(unsigned* p, unsigned v) { return __hip_atomic_fetch_add(p, v, __ATOMIC_RELAXED, __HIP_MEMORY_SCOPE_AGENT); }
__device__ __forceinline__ unsigned xb_xcc_id() { return (unsigned)__builtin_amdgcn_s_getreg((3 << 11) | 20) & 0xFu; }
#define XB_SPIN(cond, bar) do { unsigned _sp = 0; while (cond) { __builtin_amdgcn_s_sleep(1); \
    if ((++_sp & 255u) == 0u) { if (xb_ld(&(bar)[XB_TMO])) break; if (_sp > XB_SPIN_CAP) { atomicAdd(&(bar)[XB_TMO], 1u); break; } } } } while (0)

struct XcdBarrier {
    unsigned* bar; unsigned x;
    volatile LAS unsigned* st;
};

__device__ __forceinline__ XcdBarrier xcd_barrier_post(unsigned* bar, volatile LAS unsigned* st) {
    XcdBarrier b; b.bar = bar; b.x = xb_xcc_id(); b.st = st;
    if (threadIdx.x == 0) (void)xb_add(&bar[XB_XCNT(b.x)], 1u);
    return b;
}
__device__ __forceinline__ void xcd_barrier_complete(unsigned* bar, unsigned x, unsigned& nloc, unsigned& nx) {
    const unsigned G = gridDim.x * gridDim.y * gridDim.z;
    unsigned sum, cnt, mine, sp = 0u;
    for (;;) {
        sum = 0u; cnt = 0u; mine = 0u;
#pragma unroll
        for (unsigned j = 0; j < 16; ++j) { const unsigned c = xb_ld(&bar[XB_XCNT(j)]); sum += c; cnt += (c > 0u) ? 1u : 0u; mine = (j == x) ? c : mine; }
        if (sum == G) break;
        __builtin_amdgcn_s_sleep(1);
        if ((++sp & 255u) == 0u) { if (xb_ld(&bar[XB_TMO])) break; if (sp > XB_SPIN_CAP) { atomicAdd(&bar[XB_TMO], 1u); break; } }
    }
    nloc = mine > 0u ? mine : 1u; nx = cnt > 0u ? cnt : 1u;
}

__device__ __forceinline__ void xcd_barrier(const XcdBarrier& b) {
    asm volatile("s_waitcnt vmcnt(0)" ::: "memory");
    __syncthreads();
    if (threadIdx.x == 0) {
        unsigned* bar = b.bar;
        __builtin_amdgcn_s_waitcnt(0);
        unsigned nloc = b.st[0], nx = b.st[1];
        if (nloc == 0u) { xcd_barrier_complete(bar, b.x, nloc, nx); b.st[0] = nloc; b.st[1] = nx; }
        const unsigned old = xb_add(&bar[XB_XSUB(b.x)], 1u);
        const unsigned gen = old / nloc;
        if (old + 1u == (gen + 1u) * nloc) {
            __builtin_amdgcn_fence(__ATOMIC_RELEASE, "agent");
            asm volatile("s_waitcnt vmcnt(0)" ::: "memory");
            const unsigned og = xb_add(&bar[XB_TOP], 1u);
            const unsigned tg = og / nx;
            if (og + 1u == (tg + 1u) * nx) xb_add(&bar[XB_TOPGEN], 1u);
            else XB_SPIN(xb_ld(&bar[XB_TOPGEN]) == tg, bar);
            __builtin_amdgcn_fence(__ATOMIC_ACQUIRE, "agent");
            xb_add(&bar[XB_XGEN(b.x)], 1u);
            asm volatile("s_waitcnt vmcnt(0)" ::: "memory");
        } else {
            XB_SPIN(xb_ld(&bar[XB_XGEN(b.x)]) == gen, bar);
            __builtin_amdgcn_fence(__ATOMIC_ACQUIRE, "agent");
            asm volatile("s_waitcnt vmcnt(0)" ::: "memory");
        }
    }
    __syncthreads();
}

__device__ __forceinline__ void group_barrier(unsigned* ctlw, volatile LAS unsigned* gst) {
    asm volatile("s_waitcnt vmcnt(0)" ::: "memory");
    __syncthreads();
    if (threadIdx.x == 0) {
        __builtin_amdgcn_s_waitcnt(0);
        const unsigned c = blockIdx.x, ep = gst[0] + 1u; unsigned same = gst[1]; gst[0] = ep;
        unsigned* bar = ctlw + CW_BAR; unsigned* cnt = ctlw + CW_GRP + 64 * (c & 63u);
        if (same == 0u) { const unsigned* gx = ctlw + CW_GXCC + (c & 63u); const unsigned x0 = xb_ld((unsigned*)gx), x1 = xb_ld((unsigned*)gx + 64), x2 = xb_ld((unsigned*)gx + 128), x3 = xb_ld((unsigned*)gx + 192);
            same = (x0 != 0u && x0 == x1 && x0 == x2 && x0 == x3) ? 2u : 1u; gst[1] = same; }
        if (same != 2u) { __builtin_amdgcn_fence(__ATOMIC_RELEASE, "agent"); asm volatile("s_waitcnt vmcnt(0)" ::: "memory"); }
        (void)xb_add(cnt, 1u);
        XB_SPIN(xb_ld(cnt) < 4u * ep, bar);
        __builtin_amdgcn_fence(__ATOMIC_ACQUIRE, "agent");
        asm volatile("s_waitcnt vmcnt(0)" ::: "memory");
    }
    __syncthreads();
}

struct Ready { unsigned* ctlw; unsigned target; volatile LAS unsigned* known; bool on; };
__device__ __forceinline__ void batch_post(unsigned* ctlw, unsigned b) {
    asm volatile("s_waitcnt vmcnt(0)" ::: "memory");
    __syncthreads();
    if (threadIdx.x == 0) { __builtin_amdgcn_s_waitcnt(0); __builtin_amdgcn_fence(__ATOMIC_RELEASE, "agent"); asm volatile("s_waitcnt vmcnt(0)" ::: "memory"); (void)xb_add(ctlw + CW_BIN + 64 * b, 1u); }
}
__device__ __forceinline__ void ready_wait(const Ready& r, int b) {
    if (!r.on || r.known[b] >= r.target) return;
    unsigned* bar = r.ctlw + CW_BAR;
    XB_SPIN(xb_ld(r.ctlw + CW_BIN + 64 * b) < r.target, bar);
    __builtin_amdgcn_fence(__ATOMIC_ACQUIRE, "agent");
    asm volatile("s_waitcnt vmcnt(0)" ::: "memory");
    r.known[b] = r.target;
}

struct Params { const float* in[28]; float* out; unsigned char* ws; int s_lo, s_hi; };
enum { I_X = 0, I_MEM, I_POS, I_F1N, I_F1G, I_F1U, I_F1D, I_MIXN, I_WIN, I_FBIAS, I_CONVW, I_CONVB, I_LQ1, I_LK1, I_LQ2, I_LK2, I_SUBLN, I_WOUT, I_CRN, I_MEMN, I_CWQ, I_CWKV, I_CWO, I_F2N, I_F2G, I_F2U, I_F2D, I_FINN };

__device__ __forceinline__ void tr_item(const float* W, int pitch, int k0, int ncol0, bf16* WT, int K, int drow0, LAS float* scr, int lane, const float* gain) {
#pragma unroll 8
    for (int i = 0; i < 32; ++i) { const int kk = 2 * i + (lane >> 5); scr[kk * 33 + (lane & 31)] = W[(size_t)(k0 + kk) * pitch + ncol0 + (lane & 31)]; }
    LDS_WAIT(); asm volatile("" ::: "memory");
    const int c = lane & 7;
    f32x4 g0 = {1.f, 1.f, 1.f, 1.f}, g1 = g0;
    if (gain) { g0 = *(const GAS f32x4*)(gain + k0 + 8 * c); g1 = *(const GAS f32x4*)(gain + k0 + 8 * c + 4); }
#pragma unroll
    for (int j = 0; j < 4; ++j) { const int n = (lane >> 3) + 8 * j; const LAS float* s = scr + (8 * c) * 33 + n;
        v4u o; o.x = pk2(s[0 * 33] * g0.x, s[1 * 33] * g0.y); o.y = pk2(s[2 * 33] * g0.z, s[3 * 33] * g0.w); o.z = pk2(s[4 * 33] * g1.x, s[5 * 33] * g1.y); o.w = pk2(s[6 * 33] * g1.z, s[7 * 33] * g1.w);
        *(GAS v4u*)(WT + (size_t)(drow0 + n) * K + k0 + 8 * c) = o; }
    LDS_WAIT(); asm volatile("" ::: "memory");
}
constexpr int IT_GU = (D / 64) * (FF / 32), IT_DN = (FF / 64) * (D / 32), IT_INA = (D / 64) * (2304 / 32), IT_INB = (D / 64) * (3840 / 32), IT_OUT = (D / 64) * (D / 32),
              IT_Q = (D / 64) * (CRW / 32), IT_KV = (D / 64) * (2 * CRW / 32), IT_O = (CRW / 64) * (D / 32);
constexpr int IT_LAYER = 4 * IT_GU + 2 * IT_DN + IT_INA + IT_INB + IT_OUT + IT_Q + IT_KV + IT_O;

__device__ __forceinline__ void prologue_weights(const Params& p, LAS unsigned char* lds, int gw, int NGW, int wave, int lane) {
    LAS float* scr = (LAS float*)(lds + RING_OFF + wave * 16384);
    for (int it = gw; it < DEPTH * IT_LAYER; it += NGW) {
        const int l = it / IT_LAYER; int r = it % IT_LAYER;
        bf16* wl = (bf16*)(p.ws + WS_W + (size_t)l * LW_SIZE);
#define GUJOB(IDX, DSTOFF, UP, GIDX) if (r < IT_GU) { const int kb = r / (FF / 32), nb = r % (FF / 32), n0 = 32 * nb;                                                   \
            tr_item(p.in[IDX] + (size_t)l * D * FF, FF, 64 * kb, n0, (bf16*)((unsigned char*)wl + (DSTOFF)), D, (n0 >> 7) * 256 + (n0 & 127) + (UP) * 128, scr, lane, p.in[GIDX] + (size_t)l * D); continue; } r -= IT_GU;
#define PLJOB(CNT, IDX, LSTRIDE, PITCH, KDIM, NBLK, COL0, DSTOFF, DROW0, GAINP) if (r < (CNT)) { const int kb = r / (NBLK), nb = r % (NBLK);                              \
            tr_item(p.in[IDX] + (size_t)l * (LSTRIDE), PITCH, 64 * kb, (COL0) + 32 * nb, (bf16*)((unsigned char*)wl + (DSTOFF)), KDIM, (DROW0) + 32 * nb, scr, lane, GAINP); continue; } r -= (CNT);
        GUJOB(I_F1G, LW_GU1, 0, I_F1N)
        GUJOB(I_F1U, LW_GU1, 1, I_F1N)
        PLJOB(IT_DN, I_F1D, (size_t)FF * D, D, FF, D / 32, 0, LW_D1, 0, nullptr)
        GUJOB(I_F2G, LW_GU2, 0, I_F2N)
        GUJOB(I_F2U, LW_GU2, 1, I_F2N)
        PLJOB(IT_DN, I_F2D, (size_t)FF * D, D, FF, D / 32, 0, LW_D2, 0, nullptr)
        PLJOB(IT_INA, I_WIN, (size_t)D * INW, INW, D, 2304 / 32, 0, LW_IN, 0, p.in[I_MIXN] + (size_t)l * D)
        PLJOB(IT_INB, I_WIN, (size_t)D * INW, INW, D, 3840 / 32, 2310, LW_IN, 2304, p.in[I_MIXN] + (size_t)l * D)
        PLJOB(IT_OUT, I_WOUT, (size_t)D * D, D, D, D / 32, 0, LW_OUT, 0, nullptr)
        PLJOB(IT_Q, I_CWQ, (size_t)D * CRW, CRW, D, CRW / 32, 0, LW_Q, 0, p.in[I_CRN] + (size_t)l * D)
        PLJOB(IT_KV, I_CWKV, (size_t)D * 2 * CRW, 2 * CRW, D, 2 * CRW / 32, 0, LW_KV, 0, nullptr)
        PLJOB(IT_O, I_CWO, (size_t)CRW * D, D, CRW, D / 32, 0, LW_O, 0, nullptr)
#undef GUJOB
#undef PLJOB
    }
}

__device__ __forceinline__ void x_rows(const float* x, bf16* hb, unsigned long long* ssq, int gw, int NGW, int lane) {
    for (int m = gw; m < M; m += NGW) {
        const GAS f32x4* xr = (const GAS f32x4*)(x + (size_t)m * D) + lane;
        f32x4 v[8]; float s = 0.f;
#pragma unroll
        for (int j = 0; j < 8; ++j) { v[j] = xr[64 * j]; s += (v[j].x * v[j].x + v[j].y * v[j].y) + (v[j].z * v[j].z + v[j].w * v[j].w); }
        s = wave_sum(s);
        GAS v2u* o = (GAS v2u*)(hb + (size_t)m * D) + lane;
#pragma unroll
        for (int j = 0; j < 8; ++j) { v2u w; w.x = pk2(v[j].x, v[j].y); w.y = pk2(v[j].z, v[j].w); o[64 * j] = w; }
        if (lane == 0) ssq[m] = (unsigned long long)(s * pg8::SSQ_FIX);
    }
}
__device__ __forceinline__ void ff_tile(const bf16* hb, const unsigned long long* ssq, const bf16* wff  , const float* fbias, float* logfT, int m0, int wave, int lane, LAS float* xch) {
    const int fr = lane & 15, fq = lane >> 4, tile = wave & 3, kh = wave >> 2, row = m0 + tile * 16 + fr;
    const bf16* hp = hb + (size_t)row * D + kh * (D / 2) + 8 * fq; const bf16* wp = wff + (size_t)(fr < NFH ? fr : 0) * D + kh * (D / 2) + 8 * fq;
    pg8::f32x4 acc = {0.f, 0.f, 0.f, 0.f};
#pragma unroll 1
    for (int s0 = 0; s0 < D / 2 / 32; s0 += 16) {
        pg8::bf16x8 hf[16], wf[16];
#pragma unroll
        for (int s = 0; s < 16; ++s) { hf[s] = *(const GAS pg8::bf16x8*)(hp + (s0 + s) * 32); wf[s] = *(const GAS pg8::bf16x8*)(wp + (s0 + s) * 32); }
#pragma unroll
        for (int s = 0; s < 16; ++s) { const pg8::bf16x8 w = fr < NFH ? wf[s] : (pg8::bf16x8){0, 0, 0, 0, 0, 0, 0, 0}; acc = __builtin_amdgcn_mfma_f32_16x16x32_bf16(w, hf[s], acc, 0, 0, 0); }
    }
    if (kh == 1) *(LAS pg8::f32x4*)(xch + (tile * 64 + lane) * 4) = acc;
    __syncthreads();
    if (kh == 0 && fq < 2) {
        const pg8::f32x4 o = *(const LAS pg8::f32x4*)(xch + (tile * 64 + lane) * 4);
        const float rstd = 1.0f / sqrtf((float)ssq[row] * (pg8::SSQ_UNFIX / D) + EPS);
        const int b = row / SEQ, t = row % SEQ;
#pragma unroll
        for (int i = 0; i < 4; ++i) { const int j = 4 * fq + i;
            if (j < NFH) { const float z = (acc[i] + o[i]) * rstd + fbias[j]; logfT[(size_t)(b * NFH + j) * SEQ + t] = fminf(z, 0.f) - log1pf(expf(-fabsf(z))); } }
    }
}
__device__ __forceinline__ void out_norm_rows(const bf16* hb, float* out, const float* gain, int m0, int mstep, int cnt, int lane) {
    f32x4 g[8];
#pragma unroll
    for (int j = 0; j < 8; ++j) g[j] = ((const GAS f32x4*)gain)[lane + 64 * j];
    for (int k = 0; k < cnt; ++k) { const int m = m0 + k * mstep;
        const GAS v2u* xr = (const GAS v2u*)(hb + (size_t)m * D) + lane;
        f32x4 v[8]; float s = 0.f;
#pragma unroll
        for (int j = 0; j < 8; ++j) { const v2u w = xr[64 * j]; v[j] = (f32x4){bf_lo(w.x), bf_hi(w.x), bf_lo(w.y), bf_hi(w.y)}; s += (v[j].x * v[j].x + v[j].y * v[j].y) + (v[j].z * v[j].z + v[j].w * v[j].w); }
        const float rstd = 1.0f / sqrtf(wave_sum(s) * (1.0f / D) + EPS);
        GAS f32x4* o = (GAS f32x4*)(out + (size_t)m * D) + lane;
#pragma unroll
        for (int j = 0; j < 8; ++j) o[64 * j] = (v[j] * rstd) * g[j];
    }
}

__device__ __forceinline__ void memn_rows(const Params& p, int gw, int NGW, int lane) {
    bf16* dst = (bf16*)(p.ws + WS_MEMN);
    for (int m = gw; m < DEPTH * MMEM; m += NGW) {
        const int l = m / MMEM, r = m % MMEM;
        const GAS f32x4* xr = (const GAS f32x4*)(p.in[I_MEM] + (size_t)r * D) + lane; const GAS f32x4* gr = (const GAS f32x4*)(p.in[I_MEMN] + (size_t)l * D) + lane;
        f32x4 v[8]; float s = 0.f;
#pragma unroll
        for (int j = 0; j < 8; ++j) { v[j] = xr[64 * j]; s += (v[j].x * v[j].x + v[j].y * v[j].y) + (v[j].z * v[j].z + v[j].w * v[j].w); }
        const float rstd = 1.0f / sqrtf(wave_sum(s) * (1.0f / D) + EPS);
        GAS v2u* o = (GAS v2u*)(dst + (size_t)m * D) + lane;
#pragma unroll
        for (int j = 0; j < 8; ++j) { const f32x4 y = (v[j] * rstd) * gr[64 * j]; v2u w; w.x = pk2(y.x, y.y); w.y = pk2(y.z, y.w); o[64 * j] = w; }
    }
}

__device__ __forceinline__ void wff_table(const Params& p, int gtid, int GT) {
    bf16* tab = (bf16*)(p.ws + WS_WFF);
    for (int i = gtid; i < DEPTH * D; i += GT) { const int l = i / D, k = i % D; const float g = p.in[I_MIXN][i]; const float* w = p.in[I_WIN] + ((size_t)l * D + k) * INW + 2304;
#pragma unroll
        for (int j = 0; j < NFH; ++j) tab[(l * NFH + j) * D + k] = (bf16)(pk2(g * w[j], 0.f) & 0xffffu); }
}
__device__ __forceinline__ float rope_invf(int f) {
    return f == 0 ? 1.0f : f == 1 ? 0.1939227432012558f : f == 2 ? 0.03760603070259094f : f == 3 ? 0.007292664609849453f : f == 4 ? 0.0014142135623842478f : f == 5 ? 0.00027424818836152554f : f == 6 ? 5.318296098266728e-05f : 1.0313386155758053e-05f;
}
__device__ __forceinline__ void rope_table(const Params& p, int gtid, int GT) {
    float* tab = (float*)(p.ws + WS_ROPE); const int* pos = (const int*)p.in[I_POS];
    for (int i = gtid; i < M * 8; i += GT) { const int tok = i >> 3, f = i & 7;
        const float ang = (float)pos[tok] * rope_invf(f);
        double rev = (double)ang * 0.15915494309189535; rev -= __builtin_rint(rev);
        const float fr = (float)rev;
        tab[tok * 16 + f] = __builtin_amdgcn_cosf(fr); tab[tok * 16 + 8 + f] = __builtin_amdgcn_sinf(fr); }
}

__device__ __forceinline__ void conv_rows(const Params& p, int l, int i0, int i1, int GT) {
    const bf16* proj = (const bf16*)(p.ws + WS_PROJ); bf16* mix = (bf16*)(p.ws + WS_MIX);
    const float* cw = p.in[I_CONVW] + (size_t)l * 3 * CRW; const float* cbias = p.in[I_CONVB] + (size_t)l * CRW;
    for (int i = i0; i < i1; i += GT) { const int tok = i >> 6, ch0 = (i & 63) * 8, t = tok % SEQ;
        const bf16* row = proj + (size_t)tok * INP;
        float z[3][8];
#pragma unroll
        for (int d = 0; d < 3; ++d) {
            if (t >= 2 - d) { const bf16* rr = row - (size_t)(2 - d) * INP; const v4u gc = *(const GAS v4u*)(rr + C_GC + ch0), hc = *(const GAS v4u*)(rr + C_HC + ch0);
                z[d][0] = bf_lo(gc.x) * bf_lo(hc.x); z[d][1] = bf_hi(gc.x) * bf_hi(hc.x); z[d][2] = bf_lo(gc.y) * bf_lo(hc.y); z[d][3] = bf_hi(gc.y) * bf_hi(hc.y);
                z[d][4] = bf_lo(gc.z) * bf_lo(hc.z); z[d][5] = bf_hi(gc.z) * bf_hi(hc.z); z[d][6] = bf_lo(gc.w) * bf_lo(hc.w); z[d][7] = bf_hi(gc.w) * bf_hi(hc.w);
            } else {
#pragma unroll
                for (int e = 0; e < 8; ++e) z[d][e] = 0.f; } }
        const v4u gbv = *(const GAS v4u*)(row + C_GB + ch0);
        const float gb[8] = {bf_lo(gbv.x), bf_hi(gbv.x), bf_lo(gbv.y), bf_hi(gbv.y), bf_lo(gbv.z), bf_hi(gbv.z), bf_lo(gbv.w), bf_hi(gbv.w)};
        float y[8];
#pragma unroll
        for (int e = 0; e < 8; ++e) { const int ch = ch0 + e; y[e] = gb[e] * (z[0][e] * cw[ch] + z[1][e] * cw[CRW + ch] + z[2][e] * cw[2 * CRW + ch] + cbias[ch]); }
        v4u o; o.x = pk2(y[0], y[1]); o.y = pk2(y[2], y[3]); o.z = pk2(y[4], y[5]); o.w = pk2(y[6], y[7]);
        *(GAS v4u*)(mix + (size_t)tok * D + 1536 + ch0) = o; }
}

__device__ __forceinline__ int queue_next(unsigned* head, LAS unsigned char* lds) {
    __syncthreads();
    if (opaque_tid() == 0) *(volatile LAS int*)(lds + RING_OFF + at::OFF_Q) = (int)__hip_atomic_fetch_add(head, 1u, RLX_AGENT);
    __syncthreads();
    return *(volatile LAS int*)(lds + RING_OFF + at::OFF_Q);
}
__device__ __forceinline__ int queue8_search(unsigned* heads, int per_queue, int& cur, LAS unsigned char* lds, bool try_cur, const Ready& rd) {
    __syncthreads();
    const int tid = opaque_tid();
    if (tid < 64) { int c = cur, idx = -1;
        if (try_cur) { idx = __builtin_amdgcn_readfirstlane(tid == 0 ? (int)__hip_atomic_fetch_add(heads + 64 * c, 1u, RLX_AGENT) : 0); if (idx >= per_queue) idx = -1; }
        while (idx < 0) {
            const unsigned hv = tid < 8 ? __hip_atomic_load(heads + 64 * tid, RLX_AGENT) : 0xffffffffu;
            const unsigned open = (unsigned)__ballot(hv < (unsigned)per_queue) & 0xffu;
            if (open == 0u) break;
            const unsigned rot = ((open >> c) | (open << (8 - c))) & 0xffu; c = (c + __builtin_ctz(rot)) & 7;
            idx = __builtin_amdgcn_readfirstlane(tid == 0 ? (int)__hip_atomic_fetch_add(heads + 64 * c, 1u, RLX_AGENT) : 0); if (idx >= per_queue) idx = -1; }
        if (tid == 0) { if (idx >= 0) ready_wait(rd, c >> 1); volatile LAS int* q = (volatile LAS int*)(lds + RING_OFF + at::OFF_Q); q[0] = idx; q[1] = c; } }
    __syncthreads();
    volatile LAS int* q = (volatile LAS int*)(lds + RING_OFF + at::OFF_Q);
    cur = q[1]; return q[0];
}
__device__ __forceinline__ int queue8_next(unsigned* heads, int per_queue, int& cur, LAS unsigned char* lds, const Ready& rd) { return queue8_search(heads, per_queue, cur, lds, true, rd); }
__device__ __forceinline__ int queue8_take(unsigned pre, unsigned* heads, int per_queue, int& cur, LAS unsigned char* lds, const Ready& rd) {
    __syncthreads();
    if (opaque_tid() == 0) { if ((int)pre < per_queue) ready_wait(rd, cur >> 1); *(volatile LAS int*)(lds + RING_OFF + at::OFF_Q) = (int)pre; }
    __syncthreads();
    int idx = *(volatile LAS int*)(lds + RING_OFF + at::OFF_Q);
    if (idx >= per_queue) idx = queue8_search(heads, per_queue, cur, lds, false, rd);
    return idx;
}

struct KvOrder : pg8::StaticOrder {
    size_t lstride;
    __device__ __forceinline__ const char* bptr(const pg8::Gemm& g, const pg8::Unit& u, size_t tstep) const { return (const char*)g.Bt + (size_t)(u.pm >> 2) * lstride + (size_t)u.pn * tstep; }
};

#define PHFN __device__ __forceinline__
PHFN void ph_prologue(const Params& p, LAS unsigned char* lds) {
    const int tid = opaque_tid(), lane = tid & 63, wave = __builtin_amdgcn_readfirstlane(tid >> 6);
    const int G = gridDim.x, gw = blockIdx.x * NWAVES + wave, NGW = G * NWAVES, gtid = blockIdx.x * NTHR + tid, GT = G * NTHR;
    prologue_weights(p, lds, gw, NGW, wave, lane);
    rope_table(p, gtid, GT);
    memn_rows(p, gw, NGW, lane);
    wff_table(p, gtid, GT);
    x_rows(p.in[I_X], (bf16*)(p.ws + WS_NB), (unsigned long long*)(p.ws + WS_SSQ), gw, NGW, lane);
}
PHFN void local_rows(int wave, int& m0, int& mstep, int& cnt) {
    const int c = (int)blockIdx.x;
    if (gridDim.x == 256) { m0 = ((c & 7) * 8 + ((c >> 3) & 7)) * 256 + (c >> 6) * 64 + wave * 8; mstep = 1; cnt = 8; }
    else { m0 = c * NWAVES + wave; mstep = (int)gridDim.x * NWAVES; cnt = (M - m0 + mstep - 1) / mstep; }
}
PHFN void ph_norm_out(const bf16* hb, float* out, const float* gain) {
    const int tid = opaque_tid(), lane = tid & 63, wave = __builtin_amdgcn_readfirstlane(tid >> 6);
    int m0, mstep, cnt; local_rows(wave, m0, mstep, cnt);
    out_norm_rows(hb, out, gain, m0, mstep, cnt, lane);
}
PHFN void ph_ff(const bf16* h, const unsigned long long* ssq, const bf16* wfft  , const float* fbias, float* logfT, LAS unsigned char* lds) {
    const int tid = opaque_tid(), lane = tid & 63, wave = __builtin_amdgcn_readfirstlane(tid >> 6), c = (int)blockIdx.x;
    if (gridDim.x == 256) ff_tile(h, ssq, wfft, fbias, logfT, ((c & 7) * 8 + ((c >> 3) & 7)) * 256 + (c >> 6) * 64, wave, lane, (LAS float*)(lds + RING_OFF));
    else for (int tb = c; tb < M / 64; tb += (int)gridDim.x) { ff_tile(h, ssq, wfft, fbias, logfT, tb * 64, wave, lane, (LAS float*)(lds + RING_OFF)); __syncthreads(); }
    __syncthreads();
}
PHFN void ph_gemm_kv(LAS unsigned char* lds, const bf16* A, const bf16* Bt, bf16* O) {
    pg8::Gemm g{A, Bt, DEPTH * MMEM, 2 * CRW, D};
    KvOrder S; S.init(DEPTH * MMEM, 2 * CRW, gridDim.x, (int)blockIdx.x); S.lstride = LW_SIZE;
    pg8::EpiBf16 E{{nullptr, (LAS float*)(lds + RSC_OFF)}, O, 2 * CRW, nullptr, 0, 0};
    pg8::gemm_phase<pg8::EpiBf16, KvOrder, true, true>(lds + RING_OFF, g, S, E);
}
PHFN void ph_gemm_swiglu(LAS unsigned char* lds, const bf16* A, const bf16* Bt, bf16* O, const unsigned long long* ssq, int fixedp = 0) {
    pg8::Gemm g{A, Bt, M, NGU, D};
    pg8::StaticOrder S; S.init(M, NGU, gridDim.x, (int)blockIdx.x); S.fixedp = fixedp;
    pg8::EpiSwiglu E{{ssq, (LAS float*)(lds + RSC_OFF)}, O, FF};
    pg8::gemm_phase<pg8::EpiSwiglu, pg8::StaticOrder, true, true>(lds + RING_OFF, g, S, E);
}
PHFN void ph_gemm_resid(LAS unsigned char* lds, const bf16* A, const bf16* Bt, int K, bf16* hb, unsigned long long* ssq, float s) {
    pg8::Gemm g{A, Bt, M, D, K};
    pg8::StaticOrder S; S.init(M, D, gridDim.x, (int)blockIdx.x);
    pg8::EpiResid E{hb, ssq, D, s, (LAS float*)(lds + RED_OFF)};
    pg8::gemm_phase<pg8::EpiResid, pg8::StaticOrder, true, true>(lds + RING_OFF, g, S, E);
}
PHFN void ph_gemm_bf16(LAS unsigned char* lds, const bf16* A, const bf16* Bt, int N, bf16* O, const unsigned long long* ssq, const float* rope) {
    pg8::Gemm g{A, Bt, M, N, D};
    pg8::StaticOrder S; S.init(M, N, gridDim.x, (int)blockIdx.x);
    pg8::EpiBf16 E{{ssq, (LAS float*)(lds + RSC_OFF)}, O, N, rope, C_DQ / 256, C_DV / 256};
    pg8::gemm_phase<pg8::EpiBf16, pg8::StaticOrder, false, true>(lds + RING_OFF, g, S, E);
}
PHFN void ph_conv(const Params& p, int l, unsigned* head, LAS unsigned char* lds, const Ready& rd) {
    constexpr int CHUNK = 2 * NTHR, NCHUNK = M * 64 / CHUNK;
    if (opaque_tid() == 0) { for (int b = 0; b < BATCH; ++b) ready_wait(rd, b); }
    int c = queue_next(head, lds);
    while (c < NCHUNK) {
        const int tid = opaque_tid();
        const unsigned pre = tid == 0 ? __hip_atomic_fetch_add(head, 1u, RLX_AGENT) : 0u;
        conv_rows(p, l, c * CHUNK + tid, (c + 1) * CHUNK, NTHR);
        __syncthreads();
        if (tid == 0) *(volatile LAS int*)(lds + RING_OFF + at::OFF_Q) = (int)pre;
        __syncthreads();
        c = *(volatile LAS int*)(lds + RING_OFF + at::OFF_Q);
    }
}
PHFN void ph_attn_fox(LAS unsigned char* lds, const bf16* PROJ, const float* LOGF, bf16* MIX, unsigned* heads, const Ready& rd) {
    int cur = (int)(xb_xcc_id() & 7u);
    for (int idx = queue8_next(heads, 48, cur, lds, rd); idx >= 0; ) {
        unsigned pre = 0u;
        const int qb = 15 - idx / 3, b = cur >> 1, h = (cur & 1) * 3 + idx % 3; const size_t tok0 = (size_t)b * SEQ;
        at::attn_unit<0>((LAS char*)(lds + RING_OFF), PROJ + (tok0 + qb * 256) * INP + C_FQ + h * 128, INP, PROJ + tok0 * INP + C_FK + h * 128, PROJ + tok0 * INP + C_FV + h * 128, INP,
                         LOGF + (size_t)(b * NFH + h) * SEQ, qb * 256, 4 * (qb + 1), MIX + (tok0 + qb * 256) * D + h * 128, D, 0.f, nullptr, 0.f, heads + 64 * cur, pre);
        idx = queue8_take(pre, heads, 48, cur, lds, rd);
    }
}
PHFN void ph_attn_diff(LAS unsigned char* lds, const bf16* PROJ, bf16* MIX, unsigned* heads, const float* lq1, const float* lk1, const float* lq2, const float* lk2, const float* subg, int l, const Ready& rd) {
    const int lane = opaque_tid() & 63;
    const float lam_init = 0.8f - 0.6f * expf(-0.3f * (float)l);
    const float lam = expf(wave_sum(lq1[lane] * lk1[lane])) - expf(wave_sum(lq2[lane] * lk2[lane])) + lam_init;
    int cur = (int)(xb_xcc_id() & 7u);
    for (int idx = queue8_next(heads, 96, cur, lds, rd); idx >= 0; ) {
        unsigned pre = 0u;
        const int qb = 31 - idx / 3, b = cur >> 1, h = (cur & 1) * 3 + idx % 3; const size_t tok0 = (size_t)b * SEQ;
        at::attn_unit<1>((LAS char*)(lds + RING_OFF), PROJ + (tok0 + qb * 128) * INP + C_DQ + h * 128, INP, PROJ + tok0 * INP + C_DK + h * 128, PROJ + tok0 * INP + C_DV + h * 128, INP,
                         nullptr, qb * 128, 2 * (qb + 1), MIX + (tok0 + qb * 128) * D + 768 + h * 128, D, lam, subg, 1.0f - lam_init, heads + 64 * cur, pre);
        idx = queue8_take(pre, heads, 96, cur, lds, rd);
    }
}
PHFN void ph_attn_cross(LAS unsigned char* lds, const bf16* QC, const bf16* KVL  , bf16* OC) {
    for (int u = (int)blockIdx.x; u < 256; u += (int)gridDim.x) {
        const int pm = (u & 7) * 8 + ((u >> 3) & 7), h = u >> 6, b = pm >> 4; const size_t tok0 = (size_t)pm * 256; unsigned nopre = 0u;
        const bf16* kv = KVL + (size_t)(b * MEMLEN) * (2 * CRW) + h * 128;
        at::attn_unit<2>((LAS char*)(lds + RING_OFF), QC + tok0 * CRW + h * 128, CRW, kv, kv + CRW, 2 * CRW, nullptr, 0, MEMLEN / 64, OC + tok0 * CRW + h * 128, CRW, 0.f, nullptr, 0.f, nullptr, nopre);
    }
}

#ifndef PROBE_DUP
#define PROBE_DUP 0
#endif
constexpr int N_STEPS = 2 + 8 * 2 + DEPTH * 6 + 1;
__global__ void __launch_bounds__(NTHR, 2) fwd(Params p) {
    extern __shared__ __attribute__((aligned(16))) unsigned char lds_raw[];
    LAS unsigned char* lds = (LAS unsigned char*)lds_raw;
    const int tid = threadIdx.x;
    unsigned* ctl = (unsigned*)(p.ws + WS_CTL);
    for (int u = tid; u < (LDS_BYTES - LDSCTL_OFF) / 4; u += NTHR) ((LAS unsigned*)(lds + LDSCTL_OFF))[u] = 0u;
    __syncthreads();
    XcdBarrier bar; bar.bar = ctl + CW_BAR; bar.x = 0; bar.st = nullptr;
    if (p.s_hi - p.s_lo > 1) bar = xcd_barrier_post(ctl + CW_BAR, (volatile LAS unsigned*)(lds + MISC_OFF) + 8);
    if (tid == 0) __hip_atomic_store(ctl + CW_GXCC + blockIdx.x, xb_xcc_id() + 1u, __ATOMIC_RELAXED, __HIP_MEMORY_SCOPE_AGENT);
    const bool grouped = gridDim.x == 256 && p.s_hi - p.s_lo > 1;
    int cur = 0;
#if PROBE_DUP & 512
#define PH_ENDG  if (cur + 1 < p.s_hi) { if (grouped) { group_barrier(ctl, (volatile LAS unsigned*)(lds + MISC_OFF) + 10); group_barrier(ctl, (volatile LAS unsigned*)(lds + MISC_OFF) + 10); group_barrier(ctl, (volatile LAS unsigned*)(lds + MISC_OFF) + 10); } else xcd_barrier(bar); } } ++cur;
#elif PROBE_DUP & 16384
#define PH_ENDG  if (cur + 1 < p.s_hi) { __syncthreads(); const unsigned long long t0_ = wall_clock64(); if (grouped) group_barrier(ctl, (volatile LAS unsigned*)(lds + MISC_OFF) + 10); else xcd_barrier(bar); if (tid == 0) ((LAS unsigned*)(lds + MISC_OFF))[14] += (unsigned)(wall_clock64() - t0_); } } ++cur;
#else
#define PH_ENDG  if (cur + 1 < p.s_hi) { if (grouped) group_barrier(ctl, (volatile LAS unsigned*)(lds + MISC_OFF) + 10); else xcd_barrier(bar); } } ++cur;
#endif
#define PH_ENDB  if (cur + 1 < p.s_hi) { if (grouped) batch_post(ctl, (blockIdx.x & 7u) >> 1); else xcd_barrier(bar); } } ++cur;
#define PH_BEGIN if (p.s_lo <= cur && cur < p.s_hi) {
#if PROBE_DUP & 512
#define PH_END   if (cur + 1 < p.s_hi) { xcd_barrier(bar); xcd_barrier(bar); } } ++cur;
#elif PROBE_DUP & 16384
    int accw = 12;
#define PH_END   if (cur + 1 < p.s_hi) { __syncthreads(); const unsigned long long t0_ = wall_clock64(); xcd_barrier(bar); if (tid == 0) ((LAS unsigned*)(lds + MISC_OFF))[accw] += (unsigned)(wall_clock64() - t0_); accw = 12; } } ++cur;
#else
#define PH_END   if (cur + 1 < p.s_hi) xcd_barrier(bar); } ++cur;
#endif
    bf16* const HB = (bf16*)(p.ws + WS_NB); unsigned long long* ssq = (unsigned long long*)(p.ws + WS_SSQ);     bf16* const ACT = (bf16*)(p.ws + WS_ACT); bf16* const PROJ = (bf16*)(p.ws + WS_PROJ); bf16* const MIX = (bf16*)(p.ws + WS_MIX);
    bf16* const QC = (bf16*)(p.ws + WS_QC); bf16* const OC = (bf16*)(p.ws + WS_OC); bf16* const KVB = (bf16*)(p.ws + WS_KV);
    float* const LOGF = (float*)(p.ws + WS_LOGF);

    PH_BEGIN ph_prologue(p, lds);
#if PROBE_DUP & 2
        ph_prologue(p, lds);
#endif
    PH_END
    PH_BEGIN ph_gemm_kv(lds, (const bf16*)(p.ws + WS_MEMN), (const bf16*)(p.ws + WS_W + LW_KV), KVB); PH_END
    for (int j = 0; j < 2 * DEPTH; ++j) {
        const int l = j >> 1; const bool second = (j & 1) != 0;
        const unsigned char* wl = p.ws + WS_W + (size_t)l * LW_SIZE;
        PH_BEGIN
#if PROBE_DUP & 8192
            for (int rep = 0; rep < 2; ++rep)
                ph_gemm_swiglu(lds, HB, (const bf16*)(wl + (second ? LW_GU2 : LW_GU1)), rep ? PROJ : ACT, ssq, rep);
#elif PROBE_DUP & 4096
            for (int rep = 0; rep < 2; ++rep) {
                ph_gemm_swiglu(lds, HB, (const bf16*)(wl + (second ? LW_GU2 : LW_GU1)), ACT, ssq); if (rep == 0) xcd_barrier(bar); }
#else
            ph_gemm_swiglu(lds, HB, (const bf16*)(wl + (second ? LW_GU2 : LW_GU1)), ACT, ssq);
#endif
#if PROBE_DUP & 4
            ph_gemm_swiglu(lds, HB, (const bf16*)(wl + (second ? LW_GU2 : LW_GU1)), ACT, ssq);
#endif
        PH_ENDG
        PH_BEGIN ph_gemm_resid(lds, ACT, (const bf16*)(wl + (second ? LW_D2 : LW_D1)), FF, HB, ssq + M, 0.5f);
#if PROBE_DUP & 64
            ph_gemm_resid(lds, ACT, (const bf16*)(wl + (second ? LW_D2 : LW_D1)), FF, HB, (unsigned long long*)(p.ws + WS_SSQ) + 17 * (size_t)M, 0.0f);
#endif
        PH_ENDG
        ssq += M;
        if (!second) {
            PH_BEGIN
                ph_ff(HB, ssq, (const bf16*)(p.ws + WS_WFF) + (size_t)l * NFH * D, p.in[I_FBIAS] + l * NFH, LOGF, lds);
                ph_gemm_bf16(lds, HB, (const bf16*)(wl + LW_IN), INP, PROJ, ssq, (const float*)(p.ws + WS_ROPE));
#if PROBE_DUP & 16384
                accw = 15;
#endif
#if PROBE_DUP & 32
                ph_gemm_bf16(lds, HB, (const bf16*)(wl + LW_IN), INP, PROJ, ssq, (const float*)(p.ws + WS_ROPE));
#endif
            PH_ENDB
            const Ready rd{ctl, 64u * (unsigned)(l + 1), (volatile LAS unsigned*)(lds + MISC_OFF) + 16, grouped};
            PH_BEGIN
                ph_attn_fox(lds, PROJ, LOGF, MIX, ctl + CW_QUEUE + 512 * (3 * l), rd);
                ph_attn_diff(lds, PROJ, MIX, ctl + CW_QUEUE + 512 * (3 * l + 1), p.in[I_LQ1] + l * 64, p.in[I_LK1] + l * 64, p.in[I_LQ2] + l * 64, p.in[I_LK2] + l * 64, p.in[I_SUBLN] + l * 128, l, rd);
                ph_conv(p, l, ctl + CW_QUEUE + 512 * (3 * l) + 32, lds, rd);
#if PROBE_DUP & 16384
                accw = 13;
#endif
#if PROBE_DUP & 1
                ph_attn_fox(lds, PROJ, LOGF, MIX, ctl + CW_QUEUE + 512 * (12 + 3 * l), rd);
                ph_attn_diff(lds, PROJ, MIX, ctl + CW_QUEUE + 512 * (12 + 3 * l + 1), p.in[I_LQ1] + l * 64, p.in[I_LK1] + l * 64, p.in[I_LQ2] + l * 64, p.in[I_LK2] + l * 64, p.in[I_SUBLN] + l * 128, l, rd);
#endif
            PH_END
            PH_BEGIN ph_gemm_resid(lds, MIX, (const bf16*)(wl + LW_OUT), D, HB, ssq + M, 1.0f);
#if PROBE_DUP & 128
                ph_gemm_resid(lds, MIX, (const bf16*)(wl + LW_OUT), D, HB, (unsigned long long*)(p.ws + WS_SSQ) + 17 * (size_t)M, 0.0f);
#endif
            PH_ENDG
            ssq += M;
            PH_BEGIN ph_gemm_bf16(lds, HB, (const bf16*)(wl + LW_Q), CRW, QC, ssq, nullptr); PH_ENDG
            PH_BEGIN ph_attn_cross(lds, QC, KVB + (size_t)l * MMEM * 2 * CRW, OC);
#if PROBE_DUP & 16
                ph_attn_cross(lds, QC, KVB + (size_t)l * MMEM * 2 * CRW, OC);
#endif
            PH_ENDG
            PH_BEGIN ph_gemm_resid(lds, OC, (const bf16*)(wl + LW_O), CRW, HB, ssq + M, 1.0f);
#if PROBE_DUP & 256
                ph_gemm_resid(lds, OC, (const bf16*)(wl + LW_O), CRW, HB, (unsigned long long*)(p.ws + WS_SSQ) + 17 * (size_t)M, 0.0f);
#endif
            PH_ENDG
            ssq += M;
        }
    }
    PH_BEGIN ph_norm_out(HB, p.out, p.in[I_FINN]); PH_END
#if PROBE_DUP & 16384
    {   xcd_barrier(bar); unsigned* st = ctl + 8960;
        if (tid == 0) { const unsigned g = ((LAS unsigned*)(lds + MISC_OFF))[12], a = ((LAS unsigned*)(lds + MISC_OFF))[13];
            atomicMax(st + 0, g); atomicMax(st + 1, ~g); atomicAdd(st + 2, g); atomicMax(st + 3, a); atomicMax(st + 4, ~a); atomicAdd(st + 5, a);
            const unsigned gg = ((LAS unsigned*)(lds + MISC_OFF))[14]; atomicAdd(st + 6, gg); atomicMax(st + 7, ~gg);
            atomicAdd(st + 16 + (xb_xcc_id() & 7u), ((LAS unsigned*)(lds + MISC_OFF))[15]); }
        xcd_barrier(bar);
        if (blockIdx.x == 0 && tid == 0) { const int sel = (PROBE_DUP >> 16) & 7;
            unsigned xmin = 0xffffffffu, xmax = 0u; for (int j = 0; j < 8; ++j) { const unsigned s = xb_ld(st + 16 + j) / 32u; xmin = s < xmin ? s : xmin; xmax = s > xmax ? s : xmax; }
            const int sel8 = (PROBE_DUP >> 19) & 3;
            const unsigned v = sel8 == 1 ? xmin : sel8 == 2 ? xmax : sel == 0 ? xb_ld(st + 0) : sel == 1 ? ~xb_ld(st + 1) : sel == 2 ? xb_ld(st + 2) / gridDim.x : sel == 3 ? xb_ld(st + 3) : sel == 4 ? ~xb_ld(st + 4) : sel == 5 ? xb_ld(st + 5) / gridDim.x : sel == 6 ? xb_ld(st + 6) / gridDim.x : ~xb_ld(st + 7);
            const unsigned long long t0 = wall_clock64(); while (wall_clock64() - t0 < 4ull * v) __builtin_amdgcn_s_sleep(8); } }
#endif
#undef PH_BEGIN
#undef PH_END
#undef PH_ENDG
#undef PH_ENDB
}

extern "C" void kernel_launch(void* const* d_in, const int* in_sizes, int n_in, void* d_out, int out_size, void* d_ws, size_t ws_size, hipStream_t stream) {
    static int grid = 0;
    if (grid == 0) {
        if (n_in != 28 || in_sizes[0] != M * D || out_size != M * D || ws_size < WS_END) { fprintf(stderr, "kernel_launch: unexpected problem: n_in %d in0 %d out %d ws %zu (need %zu)\n", n_in, n_in > 0 ? in_sizes[0] : -1, out_size, ws_size, (size_t)WS_END); grid = -1; return; }
        int dev = 0, cus = 0, per_cu = 0;
        if (hipGetDevice(&dev) != hipSuccess || hipDeviceGetAttribute(&cus, hipDeviceAttributeMultiprocessorCount, dev) != hipSuccess) { grid = -1; return; }
        if (hipFuncSetAttribute((const void*)fwd, hipFuncAttributeMaxDynamicSharedMemorySize, LDS_BYTES) != hipSuccess) { fprintf(stderr, "kernel_launch: hipFuncSetAttribute failed\n"); grid = -1; return; }
        if (hipOccupancyMaxActiveBlocksPerMultiprocessor(&per_cu, (const void*)fwd, NTHR, LDS_BYTES) != hipSuccess || per_cu < 1) fprintf(stderr, "kernel_launch: occupancy query reports %d\n", per_cu);
        (void)hipGetLastError();
        grid = cus;
    }
    if (grid < 0) return;
    (void)hipMemsetAsync((char*)d_ws + WS_CTL, 0, CTL_ZERO_BYTES, stream);
    Params a{};
    for (int i = 0; i < 28; ++i) a.in[i] = (const float*)d_in[i];
    a.out = (float*)d_out; a.ws = (unsigned char*)d_ws;
#if MK_ONE_LAUNCH
    a.s_lo = 0; a.s_hi = N_STEPS;
    hipLaunchKernelGGL(fwd, dim3(grid), dim3(NTHR), LDS_BYTES, stream, a);
#else
    for (int s = 0; s < N_STEPS; ++s) { a.s_lo = s; a.s_hi = s + 1; hipLaunchKernelGGL(fwd, dim3(grid), dim3(NTHR), LDS_BYTES, stream, a); }
#endif
}
```

```cpp
#include <hip/hip_runtime.h>
#include <hip/hip_bf16.h>
#include <cstdio>
#include <cstdint>

#ifndef MK_ONE_LAUNCH
#define MK_ONE_LAUNCH 1
#endif
__device__ __forceinline__ int opaque_tid() { int t = (int)threadIdx.x; asm volatile("" : "+v"(t)); return t; }
namespace pg8 {
#define PG8_LAS __attribute__((address_space(3)))
typedef unsigned short bf16_t;
typedef short bf16x8 __attribute__((ext_vector_type(8)));
typedef float f32x4 __attribute__((ext_vector_type(4)));
typedef unsigned u32x4 __attribute__((ext_vector_type(4)));
constexpr int BM = 256, BK = 64, HALF = 128, HTB = HALF * BK * 2  , STAGE_BYTES = 8 * HTB, NXCD = 8, WGM = 8;

__host__ __device__ __forceinline__ int lds_byte(int r, int c) { const int st = (r >> 4) * 2 + (c >> 5), rr = r & 15, cc = c & 31, ob = rr * 64 + cc * 2; return st * 1024 + (ob ^ (((ob >> 9) & 1) << 5)); }
__host__ __device__ __forceinline__ void stage_rc(int b, int& R, int& C) { const int st = b / 1024, sb = b % 1024, swz = sb ^ (((sb >> 9) & 1) << 5); R = (st >> 1) * 16 + swz / 64; C = (st & 1) * 32 + (swz % 64) / 2; }
__host__ __device__ __forceinline__ int perm32(int rho) { const int n = rho >> 4, i = rho & 15; return 8 * (i >> 2) + 4 * n + (i & 3); }

struct Unit { int pm, pn; };
struct Gemm { const bf16_t* A; const bf16_t* Bt; int M, N, K; };

struct StaticOrder {
    int nM, nN, nwg, G, c, fixedp;
    __host__ __device__ void init(int M, int N, int G_, int c_) { nM = M / BM; nN = N / BM; nwg = nM * nN; G = G_; c = c_; fixedp = 0; }
    __host__ __device__ bool next(int i, Unit& u) const {
        const long L = (long)i * G + c; if (L >= nwg) return false;
        int wgid = (int)L; { const int q = nwg / NXCD, r = nwg % NXCD, xcd = wgid % NXCD, off = wgid / NXCD; wgid = (xcd < r ? xcd * (q + 1) : r * (q + 1) + (xcd - r) * q) + off; }
        const int nig = WGM * nN, gid = wgid / nig, fm = gid * WGM, gsz = (nM - fm) < WGM ? (nM - fm) : WGM;
        u.pm = fm + ((wgid % nig) % gsz); u.pn = (wgid % nig) / gsz; return true;
    }
    __device__ __forceinline__ void a_ready(const Unit&) const {}
    __device__ __forceinline__ void done(const Unit&) const {}
    __device__ __forceinline__ const char* aptr(const Gemm& g, const Unit& u, size_t tstep) const { return (const char*)g.A + (fixedp ? (size_t)0 : (size_t)u.pm * tstep); }
    __device__ __forceinline__ const char* bptr(const Gemm& g, const Unit& u, size_t tstep) const { return (const char*)g.Bt + (fixedp ? (size_t)0 : (size_t)u.pn * tstep); }
};

__device__ __forceinline__ unsigned cvt_pk_bf16(float lo, float hi) { unsigned r; asm volatile("v_cvt_pk_bf16_f32 %0, %1, %2" : "=v"(r) : "v"(lo), "v"(hi)); return r; }
typedef float f32x2 __attribute__((ext_vector_type(2)));

constexpr float SSQ_FIX = 1048576.0f, SSQ_UNFIX = 1.0f / 1048576.0f;
struct RowScale {
    const unsigned long long* ssq; PG8_LAS float* rs;
    __device__ __forceinline__ unsigned long long rs_load(int pm, int tid) const { return (ssq && tid < BM) ? ssq[pm * BM + tid] : 0ull; }
    __device__ __forceinline__ void rs_store(unsigned long long v, int par, int tid) const { if (tid < BM) rs[(par & 1) * BM + tid] = ssq ? __builtin_amdgcn_rsqf((float)v * (SSQ_UNFIX / 2048.0f) + 1e-6f) : 1.0f; }
    __device__ __forceinline__ void get(int ui, int wr, int fr, float (&r)[2][4]) const {
#pragma unroll
        for (int ai = 0; ai < 2; ++ai)
#pragma unroll
            for (int m = 0; m < 4; ++m) r[ai][m] = rs[(ui & 1) * BM + ai * HALF + wr * 64 + m * 16 + fr]; }
};
struct EpiBf16 : RowScale {
    static constexpr bool PERM = true, AFTER_DRAIN = false, ROWSCALE = true;
    bf16_t* O; int ldc; const float* rope; int rope_lo, rope_hi;
    __device__ __forceinline__ void operator()(const f32x4 (&acc)[2][2][4][2], const Unit& u, int wr, int wc, int fr, int fq, int ui) const {
        const int row0 = u.pm * BM + wr * 64 + fr; const int col0 = u.pn * BM + wc * 32 + 8 * fq;
        float rsv[2][4]; get(ui, wr, fr, rsv);
        const bool rot = rope != nullptr && u.pn >= rope_lo && u.pn < rope_hi && (wc & 1) == 0;
#pragma unroll
        for (int ai = 0; ai < 2; ++ai)
#pragma unroll
            for (int m = 0; m < 4; ++m) { const int row = row0 + ai * HALF + m * 16; bf16_t* rowp = O + (size_t)row * ldc + col0; const float r = rsv[ai][m];
                f32x4 cs0 = {1.f, 1.f, 1.f, 1.f}, cs1 = cs0, sn0 = {0.f, 0.f, 0.f, 0.f}, sn1 = sn0;
                if (rot) { const f32x4* tr = (const f32x4*)(rope + (size_t)row * 16); cs0 = tr[0]; cs1 = tr[1]; sn0 = tr[2]; sn1 = tr[3];
                    if (fq == 0) { sn0 = -sn0; sn1 = -sn1; } else if (fq > 1) { cs0 = (f32x4){1.f, 1.f, 1.f, 1.f}; cs1 = cs0; sn0 = (f32x4){0.f, 0.f, 0.f, 0.f}; sn1 = sn0; } }
#pragma unroll
                for (int bj = 0; bj < 2; ++bj) { f32x4 v0 = acc[ai][bj][m][0] * r, v1 = acc[ai][bj][m][1] * r;
                    if (rot) { f32x4 p0, p1;
#pragma unroll
                        for (int e = 0; e < 4; ++e) { p0[e] = __shfl_xor(v0[e], 16); p1[e] = __shfl_xor(v1[e], 16); }
                        v0 = v0 * cs0 + p0 * sn0; v1 = v1 * cs1 + p1 * sn1; }
                    u32x4 w; w.x = cvt_pk_bf16(v0[0], v0[1]); w.y = cvt_pk_bf16(v0[2], v0[3]); w.z = cvt_pk_bf16(v1[0], v1[1]); w.w = cvt_pk_bf16(v1[2], v1[3]);
                    *(u32x4*)(rowp + bj * HALF) = w; } }
    }
};
__device__ __forceinline__ float silu_mul(float g, float u) { return g * u * __builtin_amdgcn_rcpf(1.0f + __builtin_amdgcn_exp2f(-1.4426950408889634f * g)); }
struct EpiSwiglu : RowScale {
    static constexpr bool PERM = true, AFTER_DRAIN = false, ROWSCALE = true;
    bf16_t* O; int ldc;
    __device__ __forceinline__ void operator()(const f32x4 (&acc)[2][2][4][2], const Unit& u, int wr, int wc, int fr, int fq, int ui) const {
        const int row0 = u.pm * BM + wr * 64 + fr; const int col0 = u.pn * HALF + wc * 32 + 8 * fq;
        float rsv[2][4]; get(ui, wr, fr, rsv);
#pragma unroll
        for (int ai = 0; ai < 2; ++ai)
#pragma unroll
            for (int m = 0; m < 4; ++m) { bf16_t* rowp = O + (size_t)(row0 + ai * HALF + m * 16) * ldc + col0; const float r = rsv[ai][m];
                const f32x4 g0 = acc[ai][0][m][0] * r, g1 = acc[ai][0][m][1] * r, u0 = acc[ai][1][m][0] * r, u1 = acc[ai][1][m][1] * r;
                u32x4 w; w.x = cvt_pk_bf16(silu_mul(g0[0], u0[0]), silu_mul(g0[1], u0[1])); w.y = cvt_pk_bf16(silu_mul(g0[2], u0[2]), silu_mul(g0[3], u0[3]));
                w.z = cvt_pk_bf16(silu_mul(g1[0], u1[0]), silu_mul(g1[1], u1[1])); w.w = cvt_pk_bf16(silu_mul(g1[2], u1[2]), silu_mul(g1[3], u1[3]));
                *(u32x4*)rowp = w; }
    }
};
__device__ __forceinline__ float bfl(unsigned w) { return __builtin_bit_cast(float, w << 16); }
__device__ __forceinline__ float bfh(unsigned w) { return __builtin_bit_cast(float, w & 0xffff0000u); }
struct EpiResid {
    static constexpr bool PERM = true, AFTER_DRAIN = false, ROWSCALE = false;
    bf16_t* hb; unsigned long long* ssq; int ldc; float s; PG8_LAS float* red;
    __device__ __forceinline__ void operator()(const f32x4 (&acc)[2][2][4][2], const Unit& u, int wr, int wc, int fr, int fq, int) const {
        const int row0 = u.pm * BM + wr * 64 + fr; const int col0 = u.pn * BM + wc * 32 + 8 * fq;
        u32x4 pre[8][2];
#pragma unroll
        for (int g = 0; g < 8; ++g) { const size_t off = (size_t)(row0 + (g >> 2) * HALF + (g & 3) * 16) * ldc + col0;
#pragma unroll
            for (int bj = 0; bj < 2; ++bj) pre[g][bj] = *(const u32x4*)(hb + off + bj * HALF); }
#pragma unroll
        for (int g = 0; g < 8; ++g) { const int ai = g >> 2, m = g & 3; const size_t off = (size_t)(row0 + ai * HALF + m * 16) * ldc + col0; float q = 0.f;
#pragma unroll
            for (int bj = 0; bj < 2; ++bj) { const u32x4 b = pre[g][bj];
                const f32x4 v0 = (f32x4){bfl(b.x), bfh(b.x), bfl(b.y), bfh(b.y)} + acc[ai][bj][m][0] * s, v1 = (f32x4){bfl(b.z), bfh(b.z), bfl(b.w), bfh(b.w)} + acc[ai][bj][m][1] * s;
                u32x4 w; w.x = cvt_pk_bf16(v0[0], v0[1]); w.y = cvt_pk_bf16(v0[2], v0[3]); w.z = cvt_pk_bf16(v1[0], v1[1]); w.w = cvt_pk_bf16(v1[2], v1[3]);
                *(u32x4*)(hb + off + bj * HALF) = w;
                q += (v0[0] * v0[0] + v0[1] * v0[1]) + (v0[2] * v0[2] + v0[3] * v0[3]) + (v1[0] * v1[0] + v1[1] * v1[1]) + (v1[2] * v1[2] + v1[3] * v1[3]); }
            { auto r16 = __builtin_amdgcn_permlane16_swap(__float_as_uint(q), __float_as_uint(q), false, false); q = __uint_as_float(r16[0]) + __uint_as_float(r16[1]);
              auto r32 = __builtin_amdgcn_permlane32_swap(__float_as_uint(q), __float_as_uint(q), false, false); q = __uint_as_float(r32[0]) + __uint_as_float(r32[1]); }
            if (fq == 0) red[wc * BM + ai * HALF + wr * 64 + m * 16 + fr] = q; }
        asm volatile("s_waitcnt lgkmcnt(0)" ::: "memory"); __builtin_amdgcn_s_barrier(); asm volatile("" ::: "memory");
        const int t = wr * 256 + wc * 64 + fq * 16 + fr;
        if (t < BM) { const float sum = (red[t] + red[BM + t]) + (red[2 * BM + t] + red[3 * BM + t]);
            (void)__hip_atomic_fetch_add(ssq + u.pm * BM + t, (unsigned long long)(sum * SSQ_FIX), __ATOMIC_RELAXED, __HIP_MEMORY_SCOPE_AGENT); }
        asm volatile("s_waitcnt lgkmcnt(0)" ::: "memory"); __builtin_amdgcn_s_barrier(); asm volatile("" ::: "memory");
    }
};
template <class Epi, class Sched, bool ALIGN_EPI = false, bool SP2 = false>
__device__ __forceinline__ void gemm_phase(PG8_LAS unsigned char* lds, const Gemm g, const Sched& S, const Epi& E) {
    const int tid = opaque_tid(), wid = __builtin_amdgcn_readfirstlane(tid >> 6), lane = tid & 63, wr = wid >> 2, wc = wid & 3, fr = lane & 15, fq = lane >> 4;
    const int K = g.K, nt = K / BK;
    unsigned voffA[2], voffB[2];
#pragma unroll
    for (int i = 0; i < 2; ++i) { int R, C; stage_rc(tid * 16 + i * 8192, R, C); const int Rb = Epi::PERM ? ((R & ~31) + perm32(R & 31)) : R;
        voffA[i] = (unsigned)(R * K + C) * 2u; voffB[i] = (unsigned)(Rb * K + C) * 2u; }
    const size_t kstep = (size_t)(BK * 2);
    const size_t hstep = (size_t)HALF * K * 2;
    const size_t tstep = 2 * hstep;
    const unsigned ldsw = (unsigned)wid * 1024u;
    const int aoff = lds_byte(wr * 64 + fr, fq * 8), boff = lds_byte(wc * 32 + fr, fq * 8);
#define PG8_SA(b, h) (((b) * 2 + (h)) * HTB)
#define PG8_SB(b, h) ((4 + (b) * 2 + (h)) * HTB)
#define PG8_STAGE(bufoff, gbase, voff) do { _Pragma("unroll") for (int _i = 0; _i < 2; ++_i) \
        __builtin_amdgcn_global_load_lds((const unsigned*)((const char*)(gbase) + (voff)[_i]), (PG8_LAS unsigned*)(lds + (bufoff) + ldsw + _i * 8192), 16, 0, 0); } while (0)
#define PG8_LDA(dst, b, h) do { _Pragma("unroll") for (int m = 0; m < 4; ++m) _Pragma("unroll") for (int k = 0; k < 2; ++k) dst[m][k] = *(const PG8_LAS bf16x8*)(lds + PG8_SA(b, h) + aoff + m * 2048 + k * 1024); } while (0)
#define PG8_LDB(dst, b, h) do { _Pragma("unroll") for (int n = 0; n < 2; ++n) _Pragma("unroll") for (int k = 0; k < 2; ++k) dst[n][k] = *(const PG8_LAS bf16x8*)(lds + PG8_SB(b, h) + boff + n * 2048 + k * 1024); } while (0)
#define PG8_MMA(ai, bj, At, Bt) do { __builtin_amdgcn_s_setprio(1); _Pragma("unroll") for (int m = 0; m < 4; ++m) _Pragma("unroll") for (int n = 0; n < 2; ++n) _Pragma("unroll") for (int k = 0; k < 2; ++k) \
        acc[ai][bj][m][n] = __builtin_amdgcn_mfma_f32_16x16x32_bf16(Bt[n][k], At[m][k], acc[ai][bj][m][n], 0, 0, 0); __builtin_amdgcn_s_setprio(0); } while (0)
#define PG8_WAIT_V(n) asm volatile("s_waitcnt vmcnt(" #n ")" ::: "memory")
#define PG8_WAIT_L(n) asm volatile("s_waitcnt lgkmcnt(" #n ")" ::: "memory")
#define PG8_BAR __builtin_amdgcn_s_barrier()
#define PG8_SCHED __builtin_amdgcn_sched_barrier(0)
    Unit cur, nxt; int ui = 0;
    if (!S.next(0, cur)) return;
    f32x4 acc[2][2][4][2];
#pragma unroll
    for (int a = 0; a < 2; ++a)
#pragma unroll
        for (int b = 0; b < 2; ++b)
#pragma unroll
            for (int m = 0; m < 4; ++m)
#pragma unroll
                for (int n = 0; n < 2; ++n) acc[a][b][m][n] = (f32x4){0.f, 0.f, 0.f, 0.f};
    bf16x8 At[4][2], B0[2][2], B1[2][2];
    const char* cA = S.aptr(g, cur, tstep); const char* cB = S.bptr(g, cur, tstep);
    S.a_ready(cur);
    if constexpr (Epi::ROWSCALE) E.rs_store(E.rs_load(cur.pm, tid), 0, tid);
    if constexpr (SP2) {
        PG8_STAGE(PG8_SB(0, 0), cB, voffB); PG8_STAGE(PG8_SB(0, 1), cB + hstep, voffB); PG8_STAGE(PG8_SA(0, 0), cA, voffA); PG8_STAGE(PG8_SA(0, 1), cA + hstep, voffA);
        if (wr == 1) PG8_BAR;
        PG8_WAIT_V(2); PG8_BAR;
        PG8_STAGE(PG8_SB(1, 0), cB + kstep, voffB); PG8_STAGE(PG8_SA(1, 0), cA + kstep, voffA); PG8_STAGE(PG8_SB(1, 1), cB + hstep + kstep, voffB);
        PG8_WAIT_V(6); PG8_BAR;
    } else {
        PG8_STAGE(PG8_SB(0, 0), cB, voffB); PG8_STAGE(PG8_SA(0, 0), cA, voffA); PG8_STAGE(PG8_SB(0, 1), cB + hstep, voffB); PG8_STAGE(PG8_SA(0, 1), cA + hstep, voffA);
        if (wr == 1) PG8_BAR;
        PG8_WAIT_V(4); PG8_BAR;
        PG8_STAGE(PG8_SB(1, 0), cB + kstep, voffB); PG8_STAGE(PG8_SA(1, 0), cA + kstep, voffA); PG8_STAGE(PG8_SB(1, 1), cB + hstep + kstep, voffB);
        PG8_WAIT_V(6); PG8_BAR;
    }
    for (;;) {
        const bool has_next = S.next(ui + 1, nxt);
        const char* nA = has_next ? S.aptr(g, nxt, tstep) : cA; const char* nB = has_next ? S.bptr(g, nxt, tstep) : cB;
        for (int t = 0; t < nt; t += 2) {
            const bool last = (t == nt - 2);
            const char* a1 = cA + (size_t)(t + 1) * kstep;
            const char* a2 = last ? nA : cA + (size_t)(t + 2) * kstep; const char* b2 = last ? nB : cB + (size_t)(t + 2) * kstep;
            const char* a3 = a2 + kstep; const char* b3 = b2 + kstep;
            if (last && has_next) S.a_ready(nxt);
            if constexpr (SP2) {
            PG8_LDB(B0, 0, 0); PG8_LDB(B1, 0, 1); PG8_SCHED; PG8_LDA(At, 0, 0); PG8_STAGE(PG8_SA(1, 1), a1 + hstep, voffA);
            PG8_WAIT_V(8); PG8_WAIT_L(0); PG8_BAR; PG8_MMA(0, 0, At, B0); PG8_MMA(0, 1, At, B1); PG8_BAR; PG8_SCHED;
            PG8_LDA(At, 0, 1); PG8_STAGE(PG8_SB(0, 0), b2, voffB); PG8_STAGE(PG8_SB(0, 1), b2 + hstep, voffB); PG8_STAGE(PG8_SA(0, 0), a2, voffA);
            PG8_WAIT_V(8); PG8_WAIT_L(0); PG8_BAR; PG8_MMA(1, 0, At, B0); PG8_MMA(1, 1, At, B1); PG8_BAR; PG8_SCHED;
            PG8_LDB(B0, 1, 0); PG8_LDB(B1, 1, 1); PG8_SCHED; PG8_LDA(At, 1, 0); PG8_STAGE(PG8_SA(0, 1), a2 + hstep, voffA);
            PG8_WAIT_V(8); PG8_WAIT_L(0); PG8_BAR; PG8_MMA(0, 0, At, B0); PG8_MMA(0, 1, At, B1); PG8_BAR; PG8_SCHED;
            PG8_LDA(At, 1, 1); PG8_STAGE(PG8_SB(1, 0), b3, voffB); PG8_STAGE(PG8_SB(1, 1), b3 + hstep, voffB); PG8_STAGE(PG8_SA(1, 0), a3, voffA);
            PG8_WAIT_V(8); PG8_WAIT_L(0); PG8_BAR; PG8_MMA(1, 0, At, B0); PG8_MMA(1, 1, At, B1); PG8_BAR; PG8_SCHED;
            } else {
            PG8_LDB(B0, 0, 0); PG8_SCHED; PG8_LDA(At, 0, 0); PG8_STAGE(PG8_SA(1, 1), a1 + hstep, voffA);
            PG8_WAIT_L(8); PG8_BAR; PG8_WAIT_L(0); PG8_MMA(0, 0, At, B0); PG8_BAR; PG8_SCHED;
            PG8_LDB(B1, 0, 1); PG8_STAGE(PG8_SB(0, 0), b2, voffB);
            PG8_BAR; PG8_WAIT_L(0); PG8_MMA(0, 1, At, B1); PG8_BAR;
            PG8_LDA(At, 0, 1); PG8_STAGE(PG8_SA(0, 0), a2, voffA);
            PG8_BAR; PG8_WAIT_L(0); PG8_MMA(1, 0, At, B0); PG8_BAR; PG8_SCHED;
            PG8_STAGE(PG8_SB(0, 1), b2 + hstep, voffB);
            PG8_WAIT_V(6); PG8_BAR; PG8_MMA(1, 1, At, B1); PG8_BAR;
            PG8_LDB(B0, 1, 0); PG8_SCHED; PG8_LDA(At, 1, 0); PG8_STAGE(PG8_SA(0, 1), a2 + hstep, voffA);
            PG8_WAIT_L(8); PG8_BAR; PG8_WAIT_L(0); PG8_MMA(0, 0, At, B0); PG8_BAR; PG8_SCHED;
            PG8_LDB(B1, 1, 1); PG8_STAGE(PG8_SB(1, 0), b3, voffB);
            PG8_BAR; PG8_WAIT_L(0); PG8_MMA(0, 1, At, B1); PG8_BAR;
            PG8_LDA(At, 1, 1); PG8_STAGE(PG8_SA(1, 0), a3, voffA);
            PG8_BAR; PG8_WAIT_L(0); PG8_MMA(1, 0, At, B0); PG8_BAR; PG8_SCHED;
            PG8_STAGE(PG8_SB(1, 1), b3 + hstep, voffB);
            PG8_WAIT_V(6); PG8_BAR; PG8_MMA(1, 1, At, B1); PG8_BAR;
            }
        }
        if constexpr (ALIGN_EPI) { if (wr == 0) PG8_BAR; }
        if constexpr (!Epi::AFTER_DRAIN) {
            unsigned long long pend_ = 0ull; if constexpr (Epi::ROWSCALE) pend_ = E.rs_load(has_next ? nxt.pm : cur.pm, tid);
            E(acc, cur, wr, wc, fr, fq, ui);
            if constexpr (Epi::ROWSCALE) E.rs_store(pend_, ui + 1, tid);
            S.done(cur); }
        if (!has_next) break;
#pragma unroll
        for (int a = 0; a < 2; ++a)
#pragma unroll
            for (int b = 0; b < 2; ++b)
#pragma unroll
                for (int m = 0; m < 4; ++m)
#pragma unroll
                    for (int n = 0; n < 2; ++n) acc[a][b][m][n] = (f32x4){0.f, 0.f, 0.f, 0.f};
        cur = nxt; cA = nA; cB = nB; ++ui;
        if constexpr (ALIGN_EPI) { if (wr == 1) PG8_BAR; }
    }
    PG8_WAIT_V(0);
    if constexpr (!ALIGN_EPI) { if (wr == 0) PG8_BAR; }
    PG8_BAR;
    if constexpr (Epi::AFTER_DRAIN) { E.fused(acc, cur, wr, wc, fr, fq, lds, wid, lane); S.done(cur); }
#undef PG8_SA
#undef PG8_SB
#undef PG8_STAGE
#undef PG8_LDA
#undef PG8_LDB
#undef PG8_MMA
#undef PG8_WAIT_V
#undef PG8_WAIT_L
#undef PG8_BAR
#undef PG8_SCHED
}
}

namespace at {
#define AT_LAS __attribute__((address_space(3)))
typedef unsigned short bf16_t;
typedef short bf16x8 __attribute__((ext_vector_type(8)));
typedef short s16x4 __attribute__((ext_vector_type(4)));
typedef float f32x16 __attribute__((ext_vector_type(16)));
typedef float f32x4 __attribute__((ext_vector_type(4)));
typedef unsigned u32x4 __attribute__((ext_vector_type(4)));
constexpr int KVBLK = 64, SHM_V = 16384, SHM_K = 16384;
constexpr int OFF_V = 0, OFF_K = 2 * SHM_V, OFF_BIAS = OFF_K + 2 * SHM_K, OFF_WS = OFF_BIAS + 1024  , OFF_Q = OFF_WS + 8 * 256, OFF_X = 0  , ATT_LDS = OFF_Q + 256;
static_assert(4 * 32 * 128 * 4 <= OFF_BIAS, "exchange fits the tile buffers");
constexpr float THR = 8.f;
#ifdef PROBE_DUP
constexpr bool AT_PROBE_MFMA2 = (PROBE_DUP & 1024) != 0, AT_PROBE_VALU = (PROBE_DUP & 2048) != 0, AT_PROBE_BAR = (PROBE_DUP & 32768) != 0;
#else
constexpr bool AT_PROBE_MFMA2 = false, AT_PROBE_VALU = false, AT_PROBE_BAR = false;
#endif

#define KSWZ(row, colB) ((row) * 256 + ((colB) ^ (((row) & 7) << 4)))
#define SBAR() __builtin_amdgcn_sched_barrier(0)
__device__ __forceinline__ int v_st(int k, int c) { const int kk = (k & ~0xC) | ((k & 4) << 1) | ((k & 8) >> 1); return ((kk >> 3) * 4 + (c >> 5)) * 512 + ((kk & 7) * 32 + (c & 31)) * 2; }
__device__ __forceinline__ int v_rd_base(int lane) { return ((lane & 3) << 3) | (((lane >> 2) & 3) << 6) | (((lane >> 4) & 1) << 5) | (((lane >> 5) & 1) << 8); }
constexpr int v_rd_off(int d0, int ks, int half) { return d0 * 512 + ks * 4096 + half * 2048; }
__device__ __forceinline__ int crow(int r, int hi) { return (r & 3) + 8 * (r >> 2) + 4 * hi; }
__device__ __forceinline__ unsigned cvtpk(float lo, float hi) { unsigned r; asm volatile("v_cvt_pk_bf16_f32 %0, %1, %2" : "=v"(r) : "v"(lo), "v"(hi)); return r; }

template <int CTRL> __device__ __forceinline__ float dppf(float v) { return __builtin_bit_cast(float, __builtin_amdgcn_update_dpp(0, __builtin_bit_cast(int, v), CTRL, 0xF, 0xF, true)); }
__device__ __forceinline__ float lane_xor1(float v) { return dppf<0xB1>(v); }
__device__ __forceinline__ float sum32(float s) {
    s += dppf<0xB1>(s); s += dppf<0x4E>(s);
    s += dppf<0x141>(s); s += dppf<0x140>(s);
    s += __shfl_xor(s, 16); return s; }
template <int CTRL, int RMASK> __device__ __forceinline__ float dpp0(float v) { return __builtin_bit_cast(float, __builtin_amdgcn_update_dpp(0, __builtin_bit_cast(int, v), CTRL, RMASK, 0xF, false)); }
__device__ __forceinline__ float wave_incl_scan(float x) {
    x += dpp0<0x111, 0xF>(x); x += dpp0<0x112, 0xF>(x); x += dpp0<0x114, 0xF>(x); x += dpp0<0x118, 0xF>(x);
    x += dpp0<0x142, 0xA>(x);
    x += dpp0<0x143, 0xC>(x);
    return x;
}
__device__ __forceinline__ void mask_tile(f32x16& p0, f32x16& p1, int dq, unsigned W) {
    const float NEG = -__builtin_inff();
#pragma unroll
    for (int r = 0; r < 16; ++r) {
        const int c = (r & 3) + 8 * (r >> 2);
        if ((unsigned)(dq - c) >= W) p0[r] = NEG;
        if ((unsigned)(dq - c - 32) >= W) p1[r] = NEG;
    }
}
template <int SCI> struct ScaleOf { static constexpr float v = SCI == 64 ? 0.125f : 0.08838834764831845f; };
template <int SCI>
__device__ __forceinline__ void partialSM(f32x16& p0, f32x16& p1, float& m_reg, float& mn, float& alpha) {
    constexpr float SCALE = ScaleOf<SCI>::v;
    float pmax = p0[0];
#pragma unroll
    for (int r = 1; r < 16; ++r) pmax = fmaxf(pmax, p0[r]);
#pragma unroll
    for (int r = 0; r < 16; ++r) pmax = fmaxf(pmax, p1[r]);
    { auto rr = __builtin_amdgcn_permlane32_swap(__float_as_uint(pmax), __float_as_uint(pmax), false, false);
      pmax = fmaxf(__uint_as_float(rr[0]), __uint_as_float(rr[1])); }
    constexpr float C2 = 1.4426950408889634f * SCALE;
    if (__builtin_expect(__all((pmax - m_reg) * SCALE <= THR), 1)) { mn = m_reg; alpha = 1.f; }
    else { mn = fmaxf(m_reg, pmax); alpha = __builtin_amdgcn_exp2f((m_reg - mn) * C2); m_reg = mn; }
    const float mnL = -mn * C2;
#pragma unroll
    for (int r = 0; r < 16; ++r) p0[r] = fmaf(p0[r], C2, mnL);
#pragma unroll
    for (int r = 0; r < 16; ++r) p1[r] = fmaf(p1[r], C2, mnL);
#pragma unroll
    for (int r = 0; r < 16; ++r) p0[r] = __builtin_amdgcn_exp2f(p0[r]);
}
__device__ __forceinline__ void finishSM(f32x16& p0, f32x16& p1, float alpha, float& l_reg, bf16x8& pa0, bf16x8& pa1, bf16x8& pa2, bf16x8& pa3) {
#pragma unroll
    for (int r = 0; r < 16; ++r) p1[r] = __builtin_amdgcn_exp2f(p1[r]);
    float ps = 0;
#pragma unroll
    for (int r = 0; r < 16; ++r) ps += p0[r];
#pragma unroll
    for (int r = 0; r < 16; ++r) ps += p1[r];
    { auto rr = __builtin_amdgcn_permlane32_swap(__float_as_uint(ps), __float_as_uint(ps), false, false);
      ps = __uint_as_float(rr[0]) + __uint_as_float(rr[1]); }
    l_reg = l_reg * alpha + ps;
#define PK4(P, B_, OUT) do { unsigned a0 = cvtpk(P[B_+0], P[B_+1]), a1 = cvtpk(P[B_+2], P[B_+3]);                          \
        unsigned b0 = cvtpk(P[B_+4], P[B_+5]), b1 = cvtpk(P[B_+6], P[B_+7]);                                             \
        auto r0 = __builtin_amdgcn_permlane32_swap(a0, b0, false, false); auto r1 = __builtin_amdgcn_permlane32_swap(a1, b1, false, false); \
        u32x4 w = {r0[0], r1[0], r0[1], r1[1]}; OUT = *reinterpret_cast<bf16x8*>(&w); } while (0)
    PK4(p0, 0, pa0); PK4(p0, 8, pa1); PK4(p1, 0, pa2); PK4(p1, 8, pa3);
#undef PK4
}
template <int NK, int KB>
__device__ __forceinline__ void qkt(f32x16& p0, f32x16& p1, const AT_LAS char* K_lds, int r32, int hi, const bf16x8* qr) {
    p0 = f32x16{}; p1 = f32x16{};
    const AT_LAS char* kb[4];
#pragma unroll
    for (int dd = 0; dd < 4; ++dd) kb[dd] = K_lds + KB * SHM_K + KSWZ(r32, (dd * 16 + hi * 8) * 2);
#pragma unroll
    for (int d0 = 0; d0 < NK; ++d0) { const AT_LAS char* a = kb[d0 & 3] + (d0 >> 2) * 128;
        const bf16x8 b0 = *reinterpret_cast<const AT_LAS bf16x8*>(a);
        const bf16x8 b1 = *reinterpret_cast<const AT_LAS bf16x8*>(a + 32 * 256);
        p0 = __builtin_amdgcn_mfma_f32_32x32x16_bf16(b0, qr[d0], p0, 0, 0, 0);
        p1 = __builtin_amdgcn_mfma_f32_32x32x16_bf16(b1, qr[d0], p1, 0, 0, 0); }
}
template <int D0, int KB>
__device__ __forceinline__ void qkt_load4(bf16x8 (&kf)[8], const AT_LAS char* K_lds, int r32, int hi) {
#pragma unroll
    for (int dd = 0; dd < 4; ++dd) { const AT_LAS char* a = K_lds + KB * SHM_K + KSWZ(r32, (dd * 16 + hi * 8) * 2) + (D0 >> 2) * 128;
        kf[2 * dd] = *reinterpret_cast<const AT_LAS bf16x8*>(a); kf[2 * dd + 1] = *reinterpret_cast<const AT_LAS bf16x8*>(a + 32 * 256); }
}
template <int D0>
__device__ __forceinline__ void qkt_mfma4(f32x16& p0, f32x16& p1, const bf16x8 (&kf)[8], const bf16x8* qr) {
#pragma unroll
    for (int dd = 0; dd < 4; ++dd) {
        p0 = __builtin_amdgcn_mfma_f32_32x32x16_bf16(kf[2 * dd], qr[D0 + dd], p0, 0, 0, 0);
        p1 = __builtin_amdgcn_mfma_f32_32x32x16_bf16(kf[2 * dd + 1], qr[D0 + dd], p1, 0, 0, 0); }
}
template <int VB>
__device__ __forceinline__ void pv_tile(f32x16* o, int vb0, bf16x8 pa0, bf16x8 pa1, bf16x8 pa2, bf16x8 pa3) {
#define TRRD(dst, off) asm volatile("ds_read_b64_tr_b16 %0, %1 offset:%2" : "=&v"(dst) : "v"(vb0), "i"(off) : "memory")
#define PV_D0(d0) do { s16x4 l0, l1, l2, l3, h0, h1, h2, h3; constexpr int b_ = VB * SHM_V + v_rd_off(d0, 0, 0);     \
        TRRD(l0, b_); TRRD(h0, b_ + 2048); TRRD(l1, b_ + 4096); TRRD(h1, b_ + 6144); TRRD(l2, b_ + 8192); TRRD(h2, b_ + 10240); TRRD(l3, b_ + 12288); TRRD(h3, b_ + 14336); \
        asm volatile("s_waitcnt lgkmcnt(0)" ::: "memory"); SBAR();                                                                                   \
        o[d0] = __builtin_amdgcn_mfma_f32_32x32x16_bf16(pa0, (bf16x8){l0[0], l0[1], l0[2], l0[3], h0[0], h0[1], h0[2], h0[3]}, o[d0], 0, 0, 0);   \
        o[d0] = __builtin_amdgcn_mfma_f32_32x32x16_bf16(pa1, (bf16x8){l1[0], l1[1], l1[2], l1[3], h1[0], h1[1], h1[2], h1[3]}, o[d0], 0, 0, 0);   \
        o[d0] = __builtin_amdgcn_mfma_f32_32x32x16_bf16(pa2, (bf16x8){l2[0], l2[1], l2[2], l2[3], h2[0], h2[1], h2[2], h2[3]}, o[d0], 0, 0, 0);   \
        o[d0] = __builtin_amdgcn_mfma_f32_32x32x16_bf16(pa3, (bf16x8){l3[0], l3[1], l3[2], l3[3], h3[0], h3[1], h3[2], h3[3]}, o[d0], 0, 0, 0); } while (0)
    PV_D0(0); PV_D0(1); PV_D0(2); PV_D0(3);
#undef PV_D0
#undef TRRD
}

template <int MODE>
__device__ __forceinline__ void attn_unit(AT_LAS char* lds, const bf16_t* Qp, int qpitch, const bf16_t* Kp, const bf16_t* Vp, int kvpitch, const float* cb, int q0, int NT,
                                          bf16_t* Op, int opitch, float lam, const float* subg, float outscale, unsigned* qhead, unsigned& qpre) {
    constexpr int NK = (MODE == 1) ? 4 : 8, SCI = (MODE == 1) ? 64 : 128;
    const int tid = opaque_tid(), wid = __builtin_amdgcn_readfirstlane(tid >> 6), lane = tid & 63, r32 = lane & 31, hi = lane >> 5;
    const int comp = (MODE == 1) ? (wid >> 2) : 0;
    const int wrow = (MODE == 1) ? (wid & 3) * 32 : wid * 32;
    bf16x8 qr[NK];
    { const bf16_t* qrow = Qp + (size_t)(wrow + r32) * qpitch + comp * 64 + hi * 8;
#pragma unroll
      for (int d0 = 0; d0 < NK; ++d0) qr[d0] = *reinterpret_cast<const bf16x8*>(qrow + d0 * 16); }
    AT_LAS char* V_lds = lds + OFF_V; AT_LAS char* K_lds = lds + OFF_K; AT_LAS float* bias_l = (AT_LAS float*)(lds + OFF_BIAS);
    AT_LAS float* ws = (AT_LAS float*)(lds + OFF_WS) + wid * 64; AT_LAS float* li_l = ws; AT_LAS float* al_l = ws + 32;
    const int sr = tid >> 4, sc = (tid & 15) * 8;
    const int vst0 = v_st(sr, sc), vst1 = v_st(32 + sr, sc), kws = KSWZ(sr, sc * 2);
    const int vb0 = (int)(unsigned)(uintptr_t)V_lds + v_rd_base(lane);
    const AT_LAS char* Kq = K_lds + comp * 128;
    const int qlo = q0 + wrow, qm = qlo + r32 - 4 * hi;
    float m_reg = -1e30f, l_reg = 0.f; f32x16 o[4];
#pragma unroll
    for (int d = 0; d < 4; ++d) o[d] = f32x16{};
    bf16x8 st_k0, st_k1, st_v0, st_v1; float st_b = 0.f, carry = 0.f;
    constexpr float BSC = -11.313708498984761f;
#define AT_SLOAD(i) do { if ((i) + 2 < NT) { const size_t r0_ = (size_t)(((i) + 2) * KVBLK + sr) * kvpitch + sc, r1_ = r0_ + (size_t)32 * kvpitch;              \
            st_k0 = *reinterpret_cast<const bf16x8*>(Kp + r0_); st_k1 = *reinterpret_cast<const bf16x8*>(Kp + r1_);                                     \
            if (MODE == 0) { if (tid < 64) st_b = cb[((i) + 2) * KVBLK + tid]; } }                                                                      \
        if ((i) + 1 < NT) { const size_t r0_ = (size_t)(((i) + 1) * KVBLK + sr) * kvpitch + sc, r1_ = r0_ + (size_t)32 * kvpitch;                      \
            st_v0 = *reinterpret_cast<const bf16x8*>(Vp + r0_); st_v1 = *reinterpret_cast<const bf16x8*>(Vp + r1_); } } while (0)
#define AT_SWRITE(i, KB  ) do {                                                                                                           \
        if ((i) + 1 < NT) { *reinterpret_cast<AT_LAS bf16x8*>(K_lds + (1 - (KB)) * SHM_K + kws) = st_k0; *reinterpret_cast<AT_LAS bf16x8*>(K_lds + (1 - (KB)) * SHM_K + kws + 32 * 256) = st_k1; \
            if (MODE == 0) { if (tid < 64) { const float c_ = carry + wave_incl_scan(st_b); bias_l[(((i) + 1) & 3) * 64 + tid] = c_ * BSC; carry = __builtin_bit_cast(float, __builtin_amdgcn_readlane(__builtin_bit_cast(int, c_), 63)); } } }   \
        if ((i) < NT) { *reinterpret_cast<AT_LAS bf16x8*>(V_lds + (KB) * SHM_V + vst0) = st_v0; *reinterpret_cast<AT_LAS bf16x8*>(V_lds + (KB) * SHM_V + vst1) = st_v1; } } while (0)
#define AT_RESC(a) do { if (__any((a) < 1.f)) { if (hi == 0) al_l[r32] = (a); asm volatile("s_waitcnt lgkmcnt(0)" ::: "memory");                        \
        _Pragma("unroll") for (int d_ = 0; d_ < 4; ++d_) _Pragma("unroll") for (int r = 0; r < 16; ++r) o[d_][r] *= al_l[crow(r, hi)]; } } while (0)
#define AT_ITER(i, KB) do {                                                                                                                              \
        AT_SWRITE(i, KB); AT_SLOAD(i); SBAR();                                                                                                          \
        if ((i) < NT) { qkt_load4<0, KB>(kf, Kq, r32, hi); SBAR(); }         \
        if ((i) >= 1) pv_tile<1 - (KB)>(o, vb0, pa0, pa1, pa2, pa3);                                                                                    \
        if ((i) < NT) { SBAR(); p0 = f32x16{}; p1 = f32x16{}; qkt_mfma4<0>(p0, p1, kf, qr);                                                             \
            if (NK == 8) { qkt_load4<4, KB>(kf, Kq, r32, hi); qkt_mfma4<(NK == 8 ? 4 : 0)>(p0, p1, kf, qr); } }                                         \
        if (AT_PROBE_MFMA2) { if ((i) < NT) { asm volatile("" : "+v"(p0), "+v"(p1));     \
            qkt_load4<0, KB>(kf, Kq, r32, hi); p0 = f32x16{}; p1 = f32x16{}; qkt_mfma4<0>(p0, p1, kf, qr);                                             \
            if (NK == 8) { qkt_load4<4, KB>(kf, Kq, r32, hi); qkt_mfma4<(NK == 8 ? 4 : 0)>(p0, p1, kf, qr); } } }                                       \
        SBAR(); __syncthreads();                                                                                                                        \
        if ((i) < NT) {                                                                                                                                 \
            if (MODE == 0) { const AT_LAS float* bl = bias_l + ((i) & 3) * 64 + 4 * hi;                                                                \
                _Pragma("unroll") for (int g = 0; g < 4; ++g) { const f32x4 b0_ = *reinterpret_cast<const AT_LAS f32x4*>(bl + 8 * g), b1_ = *reinterpret_cast<const AT_LAS f32x4*>(bl + 32 + 8 * g); \
                    _Pragma("unroll") for (int e = 0; e < 4; ++e) { p0[4 * g + e] += b0_[e]; p1[4 * g + e] += b1_[e]; } } }                          \
            if (MODE != 2) { const int kb_ = (i) * KVBLK; if (kb_ + KVBLK - 1 > qlo) mask_tile(p0, p1, qm - kb_, 0x7fffffffu); }                       \
            if (AT_PROBE_VALU) { float dm_ = 0.f; _Pragma("unroll") for (int q_ = 0; q_ < 128; ++q_) asm volatile("v_add_f32 %0, %0, %0" : "+v"(dm_)); }     \
            float mn_, al_; partialSM<SCI>(p0, p1, m_reg, mn_, al_);                                                                                   \
            finishSM(p0, p1, al_, l_reg, pa0, pa1, pa2, pa3);                                                                                           \
            AT_RESC(al_); }                                                                                                                             \
        SBAR(); __syncthreads(); if (AT_PROBE_BAR) { __syncthreads(); __syncthreads(); } } while (0)
#ifndef AT_GRP_BY_PARITY
#define AT_GRP_BY_PARITY 0
#endif
    const bool grpA = AT_GRP_BY_PARITY ? (wid & 1) == 0 : wid < 4;
    f32x16 p0, p1; bf16x8 pa0, pa1, pa2, pa3; bf16x8 kf[8];
    { const size_t r0_ = (size_t)sr * kvpitch + sc, r1_ = r0_ + (size_t)32 * kvpitch;
      st_k0 = *reinterpret_cast<const bf16x8*>(Kp + r0_); st_k1 = *reinterpret_cast<const bf16x8*>(Kp + r1_);
      if (MODE == 0) { if (tid < 64) st_b = cb[tid]; }
      asm volatile("s_waitcnt vmcnt(0)" ::: "memory");
      *reinterpret_cast<AT_LAS bf16x8*>(K_lds + kws) = st_k0; *reinterpret_cast<AT_LAS bf16x8*>(K_lds + kws + 32 * 256) = st_k1;
      if (MODE == 0) { if (tid < 64) { const float c_ = wave_incl_scan(st_b); bias_l[tid] = c_ * BSC; carry = __builtin_bit_cast(float, __builtin_amdgcn_readlane(__builtin_bit_cast(int, c_), 63)); } } }
    AT_SLOAD(-1);
    __syncthreads();
    if (!grpA) __syncthreads();
    for (int i = 0; i < NT; i += 2) { AT_ITER(i, 0); AT_ITER(i + 1, 1); }
    if (qhead != nullptr) { if (tid == 0) qpre = __hip_atomic_fetch_add(qhead, 1u, __ATOMIC_RELAXED, __HIP_MEMORY_SCOPE_AGENT); }
    AT_ITER(NT, 0);
    if (grpA) __syncthreads();
#undef AT_ITER
#undef AT_RESC
#undef AT_SWRITE
#undef AT_SLOAD
    if (hi == 0) li_l[r32] = l_reg;
    asm volatile("s_waitcnt lgkmcnt(0)" ::: "memory");
    float rli[16];
#pragma unroll
    for (int r = 0; r < 16; ++r) rli[r] = __builtin_amdgcn_rcpf(li_l[crow(r, hi)]);
    bf16_t* Ow = Op + (size_t)wrow * opitch;
    if (MODE != 1) {
#pragma unroll
        for (int r = 0; r < 16; ++r) { const int orow = crow(r, hi);
#pragma unroll
            for (int d0 = 0; d0 < 4; ++d0) { const float v = o[d0][r] * rli[r]; const float vn = lane_xor1(v);
                if ((r32 & 1) == 0) *(unsigned*)(Ow + (size_t)orow * opitch + d0 * 32 + r32) = cvtpk(v, vn); } }
        __syncthreads();
    } else {
        AT_LAS float* X = (AT_LAS float*)(lds + OFF_X) + (wid & 3) * 4096;
        if (comp == 1) {
#pragma unroll
            for (int r = 0; r < 16; ++r)
#pragma unroll
                for (int d0 = 0; d0 < 4; ++d0) X[crow(r, hi) * 128 + d0 * 32 + r32] = o[d0][r] * rli[r];
        }
        __syncthreads();
        if (comp == 0) {
            float g[4];
#pragma unroll
            for (int d0 = 0; d0 < 4; ++d0) g[d0] = subg[d0 * 32 + r32] * outscale;
#pragma unroll
            for (int r = 0; r < 16; ++r) { const int orow = crow(r, hi); float dv[4]; float s = 0.f;
#pragma unroll
                for (int d0 = 0; d0 < 4; ++d0) { dv[d0] = o[d0][r] * rli[r] - lam * X[orow * 128 + d0 * 32 + r32]; s += dv[d0] * dv[d0]; }
                s = sum32(s);
                const float rms = 1.0f / sqrtf(s * (1.0f / 128.0f) + 1e-6f);
#pragma unroll
                for (int d0 = 0; d0 < 4; ++d0) { const float v = dv[d0] * rms * g[d0]; const float vn = lane_xor1(v);
                    if ((r32 & 1) == 0) *(unsigned*)(Ow + (size_t)orow * opitch + d0 * 32 + r32) = cvtpk(v, vn); } }
        }
        __syncthreads();
    }
}
#undef SBAR
}

constexpr int D = 2048, BATCH = 4, SEQ = 4096, M = BATCH * SEQ, DEPTH = 4, MEMLEN = 256, MMEM = BATCH * MEMLEN;
constexpr int FF = 5632, NGU = 2 * FF, INW = 6150, INP = 6144, CRW = 512, NFH = 6;
constexpr int C_FQ = 0, C_FK = 768, C_FV = 1536, C_DQ = 2304, C_DK = 3072, C_DV = 3840, C_GB = 4608, C_GC = 5120, C_HC = 5632;
constexpr float EPS = 1e-6f;
constexpr int NWAVES = 8, NTHR = 512;
constexpr size_t MiB = 1u << 20;
constexpr size_t WS_CTL = 0, CTL_ZERO_BYTES = 4 * MiB;
constexpr size_t LW_GU1 = 0, LW_D1 = 44 * MiB, LW_GU2 = 66 * MiB, LW_D2 = 110 * MiB, LW_IN = 132 * MiB, LW_OUT = 156 * MiB, LW_Q = 164 * MiB, LW_KV = 166 * MiB, LW_O = 170 * MiB, LW_SIZE = 172 * MiB;
constexpr size_t WS_SSQ = 1 * MiB;
constexpr size_t WS_W = 4 * MiB;
constexpr size_t WS_NB = WS_W + DEPTH * LW_SIZE;
constexpr size_t WS_ACT = WS_NB + 64 * MiB;
constexpr size_t WS_PROJ = WS_ACT + 176 * MiB;
constexpr size_t WS_MIX = WS_PROJ + 192 * MiB;
constexpr size_t WS_QC = WS_MIX + 64 * MiB;
constexpr size_t WS_OC = WS_QC + 16 * MiB;
constexpr size_t WS_KV = WS_OC + 16 * MiB;
constexpr size_t WS_MEMN = WS_KV + 8 * MiB;
constexpr size_t WS_LOGF = WS_MEMN + 16 * MiB;
constexpr size_t WS_CUM = WS_LOGF + 1 * MiB;
constexpr size_t WS_ROPE = WS_CUM + 1 * MiB;
constexpr size_t WS_WFF = WS_ROPE + 1 * MiB;
constexpr size_t WS_END = WS_WFF + 1 * MiB;
static_assert(WS_SSQ + 18 * (size_t)M * 8 <= CTL_ZERO_BYTES, "ssq accumulators inside the memset region");
static_assert((size_t)NGU * D * 2 == 44 * MiB && (size_t)D * FF * 2 == 22 * MiB && (size_t)INP * D * 2 == 24 * MiB && (size_t)M * FF * 2 == 176 * MiB && (size_t)M * INP * 2 == 192 * MiB, "ws map");
constexpr int CW_BAR = 4096;
constexpr int CW_BIN = 8192;
constexpr int CW_GRP = 9216, CW_GXCC = 14336;
constexpr int CW_QUEUE = 16384;
constexpr int RING_OFF = 0, RING_BYTES = 131072;
constexpr int LDSCTL_OFF = RING_BYTES, MISC_OFF = LDSCTL_OFF + 320, RED_OFF = LDSCTL_OFF + 1024, RSC_OFF = LDSCTL_OFF + 5120;
constexpr int LDS_BYTES = 147456;
static_assert(at::ATT_LDS <= RING_BYTES, "attention scratch fits the ring region");

#define GAS __attribute__((address_space(1)))
#define LAS __attribute__((address_space(3)))
typedef unsigned short bf16;
typedef unsigned v4u __attribute__((ext_vector_type(4)));
typedef unsigned v2u __attribute__((ext_vector_type(2)));
typedef float f32x4 __attribute__((ext_vector_type(4)));
typedef float f32x2 __attribute__((ext_vector_type(2)));
typedef short bf16x8 __attribute__((ext_vector_type(8)));
typedef GAS unsigned gu32;
#define RLX_AGENT __ATOMIC_RELAXED, __HIP_MEMORY_SCOPE_AGENT
#define LDS_WAIT() asm volatile("s_waitcnt lgkmcnt(0)" ::: "memory")
#define VM_WAIT() asm volatile("s_waitcnt vmcnt(0)" ::: "memory")
__device__ __forceinline__ unsigned f2bf(float f) { unsigned u = __builtin_bit_cast(unsigned, f); return (u + 0x7fffu + ((u >> 16) & 1u)) >> 16; }
__device__ __forceinline__ unsigned pk2(float lo, float hi) { return f2bf(lo) | (f2bf(hi) << 16); }
__device__ __forceinline__ float bf_lo(unsigned w) { return __builtin_bit_cast(float, w << 16); }
__device__ __forceinline__ float bf_hi(unsigned w) { return __builtin_bit_cast(float, w & 0xffff0000u); }
template <int CTRL> __device__ __forceinline__ float dpp_f(float v) { return __builtin_bit_cast(float, __builtin_amdgcn_update_dpp(0, __builtin_bit_cast(int, v), CTRL, 0xF, 0xF, true)); }
__device__ __forceinline__ float wave_sum(float v) {
    v += dpp_f<0xB1>(v); v += dpp_f<0x4E>(v);
    v += dpp_f<0x141>(v); v += dpp_f<0x140>(v);
    v += __shfl_xor(v, 16);
    { auto rr = __builtin_amdgcn_permlane32_swap(__float_as_uint(v), __float_as_uint(v), false, false);
      v = __uint_as_float(rr[0]) + __uint_as_float(rr[1]); }
    return v;
}
#define XB_TMO      128
#define XB_XCNT(j)  (256  + 64 * (j))
#define XB_XSUB(j)  (1280 + 64 * (j))
#define XB_XGEN(j)  (2304 + 64 * (j))
#define XB_TOP      3328
#define XB_TOPGEN   3392
#define XCD_BAR_WORDS 3456
#define XB_SPIN_CAP (1u << 18)

__device__ __forceinline__ unsigned xb_ld(unsigned* p)              { return __hip_atomic_load(p, __ATOMIC_RELAXED, __HIP_MEMORY_SCOPE_AGENT); }
__device__ __forceinline__ unsigned xb_add(unsigned* p, unsigned v) { return __hip_atomic_fetch_add(p, v, __ATOMIC_RELAXED, __HIP_MEMORY_SCOPE_AGENT); }
__device__ __forceinline__ unsigned xb_xcc_id() { return (unsigned)__builtin_amdgcn_s_getreg((3 << 11) | 20) & 0xFu; }
#define XB_SPIN(cond, bar) do { unsigned _sp = 0; while (cond) { __builtin_amdgcn_s_sleep(1); \
    if ((++_sp & 255u) == 0u) { if (xb_ld(&(bar)[XB_TMO])) break; if (_sp > XB_SPIN_CAP) { atomicAdd(&(bar)[XB_TMO], 1u); break; } } } } while (0)

struct XcdBarrier {
    unsigned* bar; unsigned x;
    volatile LAS unsigned* st;
};

__device__ __forceinline__ XcdBarrier xcd_barrier_post(unsigned* bar, volatile LAS unsigned* st) {
    XcdBarrier b; b.bar = bar; b.x = xb_xcc_id(); b.st = st;
    if (threadIdx.x == 0) (void)xb_add(&bar[XB_XCNT(b.x)], 1u);
    return b;
}
__device__ __forceinline__ void xcd_barrier_complete(unsigned* bar, unsigned x, unsigned& nloc, unsigned& nx) {
    const unsigned G = gridDim.x * gridDim.y * gridDim.z;
    unsigned sum, cnt, mine, sp = 0u;
    for (;;) {
        sum = 0u; cnt = 0u; mine = 0u;
#pragma unroll
        for (unsigned j = 0; j < 16; ++j) { const unsigned c = xb_ld(&bar[XB_XCNT(j)]); sum += c; cnt += (c > 0u) ? 1u : 0u; mine = (j == x) ? c : mine; }
        if (sum == G) break;
        __builtin_amdgcn_s_sleep(1);
        if ((++sp & 255u) == 0u) { if (xb_ld(&bar[XB_TMO])) break; if (sp > XB_SPIN_CAP) { atomicAdd(&bar[XB_TMO], 1u); break; } }
    }
    nloc = mine > 0u ? mine : 1u; nx = cnt > 0u ? cnt : 1u;
}

__device__ __forceinline__ void xcd_barrier(const XcdBarrier& b) {
    asm volatile("s_waitcnt vmcnt(0)" ::: "memory");
    __syncthreads();
    if (threadIdx.x == 0) {
        unsigned* bar = b.bar;
        __builtin_amdgcn_s_waitcnt(0);
        unsigned nloc = b.st[0], nx = b.st[1];
        if (nloc == 0u) { xcd_barrier_complete(bar, b.x, nloc, nx); b.st[0] = nloc; b.st[1] = nx; }
        const unsigned old = xb_add(&bar[XB_XSUB(b.x)], 1u);
        const unsigned gen = old / nloc;
        if (old + 1u == (gen + 1u) * nloc) {
            __builtin_amdgcn_fence(__ATOMIC_RELEASE, "agent");
            asm volatile("s_waitcnt vmcnt(0)" ::: "memory");
            const unsigned og = xb_add(&bar[XB_TOP], 1u);
            const unsigned tg = og / nx;
            if (og + 1u == (tg + 1u) * nx) xb_add(&bar[XB_TOPGEN], 1u);
            else XB_SPIN(xb_ld(&bar[XB_TOPGEN]) == tg, bar);
            __builtin_amdgcn_fence(__ATOMIC_ACQUIRE, "agent");
            xb_add(&bar[XB_XGEN(b.x)], 1u);
            asm volatile("s_waitcnt vmcnt(0)" ::: "memory");
        } else {
            XB_SPIN(xb_ld(&bar[XB_XGEN(b.x)]) == gen, bar);
            __builtin_amdgcn_fence(__ATOMIC_ACQUIRE, "agent");
            asm volatile("s_waitcnt vmcnt(0)" ::: "memory");
        }
    }
    __syncthreads();
}

__device__ __forceinline__ void group_barrier(unsigned* ctlw, volatile LAS unsigned* gst) {
    asm volatile("s_waitcnt vmcnt(0)" ::: "memory");
    __syncthreads();
    if (threadIdx.x == 0) {
        __builtin_amdgcn_s_waitcnt(0);
        const unsigned c = blockIdx.x, ep = gst[0] + 1u; unsigned same = gst[1]; gst[0] = ep;
        unsigned* bar = ctlw + CW_BAR; unsigned* cnt = ctlw + CW_GRP + 64 * (c & 63u);
        if (same == 0u) { const unsigned* gx = ctlw + CW_GXCC + (c & 63u); const unsigned x0 = xb_ld((unsigned*)gx), x1 = xb_ld((unsigned*)gx + 64), x2 = xb_ld((unsigned*)gx + 128), x3 = xb_ld((unsigned*)gx + 192);
            same = (x0 != 0u && x0 == x1 && x0 == x2 && x0 == x3) ? 2u : 1u; gst[1] = same; }
        if (same != 2u) { __builtin_amdgcn_fence(__ATOMIC_RELEASE, "agent"); asm volatile("s_waitcnt vmcnt(0)" ::: "memory"); }
        (void)xb_add(cnt, 1u);
        { unsigned sp_ = 0; while (xb_ld(cnt) < 4u * ep) { if ((++sp_ & 1023u) == 0u) { if (xb_ld(&bar[XB_TMO])) break; if (sp_ > (XB_SPIN_CAP << 4)) { atomicAdd(&bar[XB_TMO], 1u); break; } } } }
        __builtin_amdgcn_fence(__ATOMIC_ACQUIRE, "agent");
        asm volatile("s_waitcnt vmcnt(0)" ::: "memory");
    }
    __syncthreads();
}

struct Ready { unsigned* ctlw; unsigned target; volatile LAS unsigned* known; bool on; };
__device__ __forceinline__ void batch_post(unsigned* ctlw, unsigned b) {
    asm volatile("s_waitcnt vmcnt(0)" ::: "memory");
    __syncthreads();
    if (threadIdx.x == 0) { __builtin_amdgcn_s_waitcnt(0); __builtin_amdgcn_fence(__ATOMIC_RELEASE, "agent"); asm volatile("s_waitcnt vmcnt(0)" ::: "memory"); (void)xb_add(ctlw + CW_BIN + 64 * b, 1u); }
}
__device__ __forceinline__ void ready_wait(const Ready& r, int b) {
    if (!r.on || r.known[b] >= r.target) return;
    unsigned* bar = r.ctlw + CW_BAR;
    XB_SPIN(xb_ld(r.ctlw + CW_BIN + 64 * b) < r.target, bar);
    __builtin_amdgcn_fence(__ATOMIC_ACQUIRE, "agent");
    asm volatile("s_waitcnt vmcnt(0)" ::: "memory");
    r.known[b] = r.target;
}

struct Params { const float* in[28]; float* out; unsigned char* ws; int s_lo, s_hi; };
enum { I_X = 0, I_MEM, I_POS, I_F1N, I_F1G, I_F1U, I_F1D, I_MIXN, I_WIN, I_FBIAS, I_CONVW, I_CONVB, I_LQ1, I_LK1, I_LQ2, I_LK2, I_SUBLN, I_WOUT, I_CRN, I_MEMN, I_CWQ, I_CWKV, I_CWO, I_F2N, I_F2G, I_F2U, I_F2D, I_FINN };

__device__ __forceinline__ void tr_item(const float* W, int pitch, int k0, int ncol0, bf16* WT, int K, int drow0, LAS float* scr, int lane, const float* gain) {
#pragma unroll 8
    for (int i = 0; i < 32; ++i) { const int kk = 2 * i + (lane >> 5); scr[kk * 33 + (lane & 31)] = W[(size_t)(k0 + kk) * pitch + ncol0 + (lane & 31)]; }
    LDS_WAIT(); asm volatile("" ::: "memory");
    const int c = lane & 7;
    f32x4 g0 = {1.f, 1.f, 1.f, 1.f}, g1 = g0;
    if (gain) { g0 = *(const GAS f32x4*)(gain + k0 + 8 * c); g1 = *(const GAS f32x4*)(gain + k0 + 8 * c + 4); }
#pragma unroll
    for (int j = 0; j < 4; ++j) { const int n = (lane >> 3) + 8 * j; const LAS float* s = scr + (8 * c) * 33 + n;
        v4u o; o.x = pk2(s[0 * 33] * g0.x, s[1 * 33] * g0.y); o.y = pk2(s[2 * 33] * g0.z, s[3 * 33] * g0.w); o.z = pk2(s[4 * 33] * g1.x, s[5 * 33] * g1.y); o.w = pk2(s[6 * 33] * g1.z, s[7 * 33] * g1.w);
        *(GAS v4u*)(WT + (size_t)(drow0 + n) * K + k0 + 8 * c) = o; }
    LDS_WAIT(); asm volatile("" ::: "memory");
}
constexpr int IT_GU = (D / 64) * (FF / 32), IT_DN = (FF / 64) * (D / 32), IT_INA = (D / 64) * (2304 / 32), IT_INB = (D / 64) * (3840 / 32), IT_OUT = (D / 64) * (D / 32),
              IT_Q = (D / 64) * (CRW / 32), IT_KV = (D / 64) * (2 * CRW / 32), IT_O = (CRW / 64) * (D / 32);
constexpr int IT_LAYER = 4 * IT_GU + 2 * IT_DN + IT_INA + IT_INB + IT_OUT + IT_Q + IT_KV + IT_O;

__device__ __forceinline__ void prologue_weights(const Params& p, LAS unsigned char* lds, int gw, int NGW, int wave, int lane) {
    LAS float* scr = (LAS float*)(lds + RING_OFF + wave * 16384);
    for (int it = gw; it < DEPTH * IT_LAYER; it += NGW) {
        const int l = it / IT_LAYER; int r = it % IT_LAYER;
        bf16* wl = (bf16*)(p.ws + WS_W + (size_t)l * LW_SIZE);
#define GUJOB(IDX, DSTOFF, UP, GIDX) if (r < IT_GU) { const int kb = r / (FF / 32), nb = r % (FF / 32), n0 = 32 * nb;                                                   \
            tr_item(p.in[IDX] + (size_t)l * D * FF, FF, 64 * kb, n0, (bf16*)((unsigned char*)wl + (DSTOFF)), D, (n0 >> 7) * 256 + (n0 & 127) + (UP) * 128, scr, lane, p.in[GIDX] + (size_t)l * D); continue; } r -= IT_GU;
#define PLJOB(CNT, IDX, LSTRIDE, PITCH, KDIM, NBLK, COL0, DSTOFF, DROW0, GAINP) if (r < (CNT)) { const int kb = r / (NBLK), nb = r % (NBLK);                              \
            tr_item(p.in[IDX] + (size_t)l * (LSTRIDE), PITCH, 64 * kb, (COL0) + 32 * nb, (bf16*)((unsigned char*)wl + (DSTOFF)), KDIM, (DROW0) + 32 * nb, scr, lane, GAINP); continue; } r -= (CNT);
        GUJOB(I_F1G, LW_GU1, 0, I_F1N)
        GUJOB(I_F1U, LW_GU1, 1, I_F1N)
        PLJOB(IT_DN, I_F1D, (size_t)FF * D, D, FF, D / 32, 0, LW_D1, 0, nullptr)
        GUJOB(I_F2G, LW_GU2, 0, I_F2N)
        GUJOB(I_F2U, LW_GU2, 1, I_F2N)
        PLJOB(IT_DN, I_F2D, (size_t)FF * D, D, FF, D / 32, 0, LW_D2, 0, nullptr)
        PLJOB(IT_INA, I_WIN, (size_t)D * INW, INW, D, 2304 / 32, 0, LW_IN, 0, p.in[I_MIXN] + (size_t)l * D)
        PLJOB(IT_INB, I_WIN, (size_t)D * INW, INW, D, 3840 / 32, 2310, LW_IN, 2304, p.in[I_MIXN] + (size_t)l * D)
        PLJOB(IT_OUT, I_WOUT, (size_t)D * D, D, D, D / 32, 0, LW_OUT, 0, nullptr)
        PLJOB(IT_Q, I_CWQ, (size_t)D * CRW, CRW, D, CRW / 32, 0, LW_Q, 0, p.in[I_CRN] + (size_t)l * D)
        PLJOB(IT_KV, I_CWKV, (size_t)D * 2 * CRW, 2 * CRW, D, 2 * CRW / 32, 0, LW_KV, 0, nullptr)
        PLJOB(IT_O, I_CWO, (size_t)CRW * D, D, CRW, D / 32, 0, LW_O, 0, nullptr)
#undef GUJOB
#undef PLJOB
    }
}

__device__ __forceinline__ void x_rows(const float* x, bf16* hb, unsigned long long* ssq, int gw, int NGW, int lane) {
    for (int m = gw; m < M; m += NGW) {
        const GAS f32x4* xr = (const GAS f32x4*)(x + (size_t)m * D) + lane;
        f32x4 v[8]; float s = 0.f;
#pragma unroll
        for (int j = 0; j < 8; ++j) { v[j] = xr[64 * j]; s += (v[j].x * v[j].x + v[j].y * v[j].y) + (v[j].z * v[j].z + v[j].w * v[j].w); }
        s = wave_sum(s);
        GAS v2u* o = (GAS v2u*)(hb + (size_t)m * D) + lane;
#pragma unroll
        for (int j = 0; j < 8; ++j) { v2u w; w.x = pk2(v[j].x, v[j].y); w.y = pk2(v[j].z, v[j].w); o[64 * j] = w; }
        if (lane == 0) ssq[m] = (unsigned long long)(s * pg8::SSQ_FIX);
    }
}
__device__ __forceinline__ void ff_tile(const bf16* hb, const unsigned long long* ssq, const bf16* wff  , const float* fbias, float* logfT, int m0, int wave, int lane, LAS float* xch) {
    const int fr = lane & 15, fq = lane >> 4, tile = wave & 3, kh = wave >> 2, row = m0 + tile * 16 + fr;
    const bf16* hp = hb + (size_t)row * D + kh * (D / 2) + 8 * fq; const bf16* wp = wff + (size_t)(fr < NFH ? fr : 0) * D + kh * (D / 2) + 8 * fq;
    pg8::f32x4 acc = {0.f, 0.f, 0.f, 0.f};
#pragma unroll 1
    for (int s0 = 0; s0 < D / 2 / 32; s0 += 16) {
        pg8::bf16x8 hf[16], wf[16];
#pragma unroll
        for (int s = 0; s < 16; ++s) { hf[s] = *(const GAS pg8::bf16x8*)(hp + (s0 + s) * 32); wf[s] = *(const GAS pg8::bf16x8*)(wp + (s0 + s) * 32); }
#pragma unroll
        for (int s = 0; s < 16; ++s) { const pg8::bf16x8 w = fr < NFH ? wf[s] : (pg8::bf16x8){0, 0, 0, 0, 0, 0, 0, 0}; acc = __builtin_amdgcn_mfma_f32_16x16x32_bf16(w, hf[s], acc, 0, 0, 0); }
    }
    if (kh == 1) *(LAS pg8::f32x4*)(xch + (tile * 64 + lane) * 4) = acc;
    __syncthreads();
    if (kh == 0 && fq < 2) {
        const pg8::f32x4 o = *(const LAS pg8::f32x4*)(xch + (tile * 64 + lane) * 4);
        const float rstd = 1.0f / sqrtf((float)ssq[row] * (pg8::SSQ_UNFIX / D) + EPS);
        const int b = row / SEQ, t = row % SEQ;
#pragma unroll
        for (int i = 0; i < 4; ++i) { const int j = 4 * fq + i;
            if (j < NFH) { const float z = (acc[i] + o[i]) * rstd + fbias[j]; logfT[(size_t)(b * NFH + j) * SEQ + t] = fminf(z, 0.f) - log1pf(expf(-fabsf(z))); } }
    }
}
__device__ __forceinline__ void out_norm_rows(const bf16* hb, float* out, const float* gain, int m0, int mstep, int cnt, int lane) {
    f32x4 g[8];
#pragma unroll
    for (int j = 0; j < 8; ++j) g[j] = ((const GAS f32x4*)gain)[lane + 64 * j];
    for (int k = 0; k < cnt; ++k) { const int m = m0 + k * mstep;
        const GAS v2u* xr = (const GAS v2u*)(hb + (size_t)m * D) + lane;
        f32x4 v[8]; float s = 0.f;
#pragma unroll
        for (int j = 0; j < 8; ++j) { const v2u w = xr[64 * j]; v[j] = (f32x4){bf_lo(w.x), bf_hi(w.x), bf_lo(w.y), bf_hi(w.y)}; s += (v[j].x * v[j].x + v[j].y * v[j].y) + (v[j].z * v[j].z + v[j].w * v[j].w); }
        const float rstd = 1.0f / sqrtf(wave_sum(s) * (1.0f / D) + EPS);
        GAS f32x4* o = (GAS f32x4*)(out + (size_t)m * D) + lane;
#pragma unroll
        for (int j = 0; j < 8; ++j) o[64 * j] = (v[j] * rstd) * g[j];
    }
}

__device__ __forceinline__ void memn_rows(const Params& p, int gw, int NGW, int lane) {
    bf16* dst = (bf16*)(p.ws + WS_MEMN);
    for (int m = gw; m < DEPTH * MMEM; m += NGW) {
        const int l = m / MMEM, r = m % MMEM;
        const GAS f32x4* xr = (const GAS f32x4*)(p.in[I_MEM] + (size_t)r * D) + lane; const GAS f32x4* gr = (const GAS f32x4*)(p.in[I_MEMN] + (size_t)l * D) + lane;
        f32x4 v[8]; float s = 0.f;
#pragma unroll
        for (int j = 0; j < 8; ++j) { v[j] = xr[64 * j]; s += (v[j].x * v[j].x + v[j].y * v[j].y) + (v[j].z * v[j].z + v[j].w * v[j].w); }
        const float rstd = 1.0f / sqrtf(wave_sum(s) * (1.0f / D) + EPS);
        GAS v2u* o = (GAS v2u*)(dst + (size_t)m * D) + lane;
#pragma unroll
        for (int j = 0; j < 8; ++j) { const f32x4 y = (v[j] * rstd) * gr[64 * j]; v2u w; w.x = pk2(y.x, y.y); w.y = pk2(y.z, y.w); o[64 * j] = w; }
    }
}

__device__ __forceinline__ void wff_table(const Params& p, int gtid, int GT) {
    bf16* tab = (bf16*)(p.ws + WS_WFF);
    for (int i = gtid; i < DEPTH * D; i += GT) { const int l = i / D, k = i % D; const float g = p.in[I_MIXN][i]; const float* w = p.in[I_WIN] + ((size_t)l * D + k) * INW + 2304;
#pragma unroll
        for (int j = 0; j < NFH; ++j) tab[(l * NFH + j) * D + k] = (bf16)(pk2(g * w[j], 0.f) & 0xffffu); }
}
__device__ __forceinline__ float rope_invf(int f) {
    return f == 0 ? 1.0f : f == 1 ? 0.1939227432012558f : f == 2 ? 0.03760603070259094f : f == 3 ? 0.007292664609849453f : f == 4 ? 0.0014142135623842478f : f == 5 ? 0.00027424818836152554f : f == 6 ? 5.318296098266728e-05f : 1.0313386155758053e-05f;
}
__device__ __forceinline__ void rope_table(const Params& p, int gtid, int GT) {
    float* tab = (float*)(p.ws + WS_ROPE); const int* pos = (const int*)p.in[I_POS];
    for (int i = gtid; i < M * 8; i += GT) { const int tok = i >> 3, f = i & 7;
        const float ang = (float)pos[tok] * rope_invf(f);
        double rev = (double)ang * 0.15915494309189535; rev -= __builtin_rint(rev);
        const float fr = (float)rev;
        tab[tok * 16 + f] = __builtin_amdgcn_cosf(fr); tab[tok * 16 + 8 + f] = __builtin_amdgcn_sinf(fr); }
}

__device__ __forceinline__ void conv_rows(const Params& p, int l, int i0, int i1, int GT) {
    const bf16* proj = (const bf16*)(p.ws + WS_PROJ); bf16* mix = (bf16*)(p.ws + WS_MIX);
    const float* cw = p.in[I_CONVW] + (size_t)l * 3 * CRW; const float* cbias = p.in[I_CONVB] + (size_t)l * CRW;
    for (int i = i0; i < i1; i += GT) { const int tok = i >> 6, ch0 = (i & 63) * 8, t = tok % SEQ;
        const bf16* row = proj + (size_t)tok * INP;
        float z[3][8];
#pragma unroll
        for (int d = 0; d < 3; ++d) {
            if (t >= 2 - d) { const bf16* rr = row - (size_t)(2 - d) * INP; const v4u gc = *(const GAS v4u*)(rr + C_GC + ch0), hc = *(const GAS v4u*)(rr + C_HC + ch0);
                z[d][0] = bf_lo(gc.x) * bf_lo(hc.x); z[d][1] = bf_hi(gc.x) * bf_hi(hc.x); z[d][2] = bf_lo(gc.y) * bf_lo(hc.y); z[d][3] = bf_hi(gc.y) * bf_hi(hc.y);
                z[d][4] = bf_lo(gc.z) * bf_lo(hc.z); z[d][5] = bf_hi(gc.z) * bf_hi(hc.z); z[d][6] = bf_lo(gc.w) * bf_lo(hc.w); z[d][7] = bf_hi(gc.w) * bf_hi(hc.w);
            } else {
#pragma unroll
                for (int e = 0; e < 8; ++e) z[d][e] = 0.f; } }
        const v4u gbv = *(const GAS v4u*)(row + C_GB + ch0);
        const float gb[8] = {bf_lo(gbv.x), bf_hi(gbv.x), bf_lo(gbv.y), bf_hi(gbv.y), bf_lo(gbv.z), bf_hi(gbv.z), bf_lo(gbv.w), bf_hi(gbv.w)};
        float y[8];
#pragma unroll
        for (int e = 0; e < 8; ++e) { const int ch = ch0 + e; y[e] = gb[e] * (z[0][e] * cw[ch] + z[1][e] * cw[CRW + ch] + z[2][e] * cw[2 * CRW + ch] + cbias[ch]); }
        v4u o; o.x = pk2(y[0], y[1]); o.y = pk2(y[2], y[3]); o.z = pk2(y[4], y[5]); o.w = pk2(y[6], y[7]);
        *(GAS v4u*)(mix + (size_t)tok * D + 1536 + ch0) = o; }
}

__device__ __forceinline__ int queue_next(unsigned* head, LAS unsigned char* lds) {
    __syncthreads();
    if (opaque_tid() == 0) *(volatile LAS int*)(lds + RING_OFF + at::OFF_Q) = (int)__hip_atomic_fetch_add(head, 1u, RLX_AGENT);
    __syncthreads();
    return *(volatile LAS int*)(lds + RING_OFF + at::OFF_Q);
}
__device__ __forceinline__ int queue8_search(unsigned* heads, int per_queue, int& cur, LAS unsigned char* lds, bool try_cur, const Ready& rd) {
    __syncthreads();
    const int tid = opaque_tid();
    if (tid < 64) { int c = cur, idx = -1;
        if (try_cur) { idx = __builtin_amdgcn_readfirstlane(tid == 0 ? (int)__hip_atomic_fetch_add(heads + 64 * c, 1u, RLX_AGENT) : 0); if (idx >= per_queue) idx = -1; }
        while (idx < 0) {
            const unsigned hv = tid < 8 ? __hip_atomic_load(heads + 64 * tid, RLX_AGENT) : 0xffffffffu;
            const unsigned open = (unsigned)__ballot(hv < (unsigned)per_queue) & 0xffu;
            if (open == 0u) break;
            const unsigned rot = ((open >> c) | (open << (8 - c))) & 0xffu; c = (c + __builtin_ctz(rot)) & 7;
            idx = __builtin_amdgcn_readfirstlane(tid == 0 ? (int)__hip_atomic_fetch_add(heads + 64 * c, 1u, RLX_AGENT) : 0); if (idx >= per_queue) idx = -1; }
        if (tid == 0) { if (idx >= 0) ready_wait(rd, c >> 1); volatile LAS int* q = (volatile LAS int*)(lds + RING_OFF + at::OFF_Q); q[0] = idx; q[1] = c; } }
    __syncthreads();
    volatile LAS int* q = (volatile LAS int*)(lds + RING_OFF + at::OFF_Q);
    cur = q[1]; return q[0];
}
__device__ __forceinline__ int queue8_next(unsigned* heads, int per_queue, int& cur, LAS unsigned char* lds, const Ready& rd) { return queue8_search(heads, per_queue, cur, lds, true, rd); }
__device__ __forceinline__ int queue8_take(unsigned pre, unsigned* heads, int per_queue, int& cur, LAS unsigned char* lds, const Ready& rd) {
    __syncthreads();
    if (opaque_tid() == 0) { if ((int)pre < per_queue) ready_wait(rd, cur >> 1); *(volatile LAS int*)(lds + RING_OFF + at::OFF_Q) = (int)pre; }
    __syncthreads();
    int idx = *(volatile LAS int*)(lds + RING_OFF + at::OFF_Q);
    if (idx >= per_queue) idx = queue8_search(heads, per_queue, cur, lds, false, rd);
    return idx;
}

struct KvOrder : pg8::StaticOrder {
    size_t lstride;
    __device__ __forceinline__ const char* bptr(const pg8::Gemm& g, const pg8::Unit& u, size_t tstep) const { return (const char*)g.Bt + (size_t)(u.pm >> 2) * lstride + (size_t)u.pn * tstep; }
};

#define PHFN __device__ __forceinline__
PHFN void ph_prologue(const Params& p, LAS unsigned char* lds) {
    const int tid = opaque_tid(), lane = tid & 63, wave = __builtin_amdgcn_readfirstlane(tid >> 6);
    const int G = gridDim.x, gw = blockIdx.x * NWAVES + wave, NGW = G * NWAVES, gtid = blockIdx.x * NTHR + tid, GT = G * NTHR;
    prologue_weights(p, lds, gw, NGW, wave, lane);
    rope_table(p, gtid, GT);
    memn_rows(p, gw, NGW, lane);
    wff_table(p, gtid, GT);
    x_rows(p.in[I_X], (bf16*)(p.ws + WS_NB), (unsigned long long*)(p.ws + WS_SSQ), gw, NGW, lane);
}
PHFN void local_rows(int wave, int& m0, int& mstep, int& cnt) {
    const int c = (int)blockIdx.x;
    if (gridDim.x == 256) { m0 = ((c & 7) * 8 + ((c >> 3) & 7)) * 256 + (c >> 6) * 64 + wave * 8; mstep = 1; cnt = 8; }
    else { m0 = c * NWAVES + wave; mstep = (int)gridDim.x * NWAVES; cnt = (M - m0 + mstep - 1) / mstep; }
}
PHFN void ph_norm_out(const bf16* hb, float* out, const float* gain) {
    const int tid = opaque_tid(), lane = tid & 63, wave = __builtin_amdgcn_readfirstlane(tid >> 6);
    int m0, mstep, cnt; local_rows(wave, m0, mstep, cnt);
    out_norm_rows(hb, out, gain, m0, mstep, cnt, lane);
}
PHFN void ph_ff(const bf16* h, const unsigned long long* ssq, const bf16* wfft  , const float* fbias, float* logfT, LAS unsigned char* lds) {
    const int tid = opaque_tid(), lane = tid & 63, wave = __builtin_amdgcn_readfirstlane(tid >> 6), c = (int)blockIdx.x;
    if (gridDim.x == 256) ff_tile(h, ssq, wfft, fbias, logfT, ((c & 7) * 8 + ((c >> 3) & 7)) * 256 + (c >> 6) * 64, wave, lane, (LAS float*)(lds + RING_OFF));
    else for (int tb = c; tb < M / 64; tb += (int)gridDim.x) { ff_tile(h, ssq, wfft, fbias, logfT, tb * 64, wave, lane, (LAS float*)(lds + RING_OFF)); __syncthreads(); }
    __syncthreads();
}
PHFN void ph_gemm_kv(LAS unsigned char* lds, const bf16* A, const bf16* Bt, bf16* O) {
    pg8::Gemm g{A, Bt, DEPTH * MMEM, 2 * CRW, D};
    KvOrder S; S.init(DEPTH * MMEM, 2 * CRW, gridDim.x, (int)blockIdx.x); S.lstride = LW_SIZE;
    pg8::EpiBf16 E{{nullptr, (LAS float*)(lds + RSC_OFF)}, O, 2 * CRW, nullptr, 0, 0};
    pg8::gemm_phase<pg8::EpiBf16, KvOrder, true, true>(lds + RING_OFF, g, S, E);
}
PHFN void ph_gemm_swiglu(LAS unsigned char* lds, const bf16* A, const bf16* Bt, bf16* O, const unsigned long long* ssq, int fixedp = 0) {
    pg8::Gemm g{A, Bt, M, NGU, D};
    pg8::StaticOrder S; S.init(M, NGU, gridDim.x, (int)blockIdx.x); S.fixedp = fixedp;
    pg8::EpiSwiglu E{{ssq, (LAS float*)(lds + RSC_OFF)}, O, FF};
    pg8::gemm_phase<pg8::EpiSwiglu, pg8::StaticOrder, true, true>(lds + RING_OFF, g, S, E);
}
PHFN void ph_gemm_resid(LAS unsigned char* lds, const bf16* A, const bf16* Bt, int K, bf16* hb, unsigned long long* ssq, float s) {
    pg8::Gemm g{A, Bt, M, D, K};
    pg8::StaticOrder S; S.init(M, D, gridDim.x, (int)blockIdx.x);
    pg8::EpiResid E{hb, ssq, D, s, (LAS float*)(lds + RED_OFF)};
    pg8::gemm_phase<pg8::EpiResid, pg8::StaticOrder, true, true>(lds + RING_OFF, g, S, E);
}
PHFN void ph_gemm_bf16(LAS unsigned char* lds, const bf16* A, const bf16* Bt, int N, bf16* O, const unsigned long long* ssq, const float* rope) {
    pg8::Gemm g{A, Bt, M, N, D};
    pg8::StaticOrder S; S.init(M, N, gridDim.x, (int)blockIdx.x);
    pg8::EpiBf16 E{{ssq, (LAS float*)(lds + RSC_OFF)}, O, N, rope, C_DQ / 256, C_DV / 256};
    pg8::gemm_phase<pg8::EpiBf16, pg8::StaticOrder, true, true>(lds + RING_OFF, g, S, E);
}
PHFN void ph_conv(const Params& p, int l, unsigned* head, LAS unsigned char* lds, const Ready& rd) {
    constexpr int CHUNK = 2 * NTHR, NCHUNK = M * 64 / CHUNK;
    if (opaque_tid() == 0) { for (int b = 0; b < BATCH; ++b) ready_wait(rd, b); }
    int c = queue_next(head, lds);
    while (c < NCHUNK) {
        const int tid = opaque_tid();
        const unsigned pre = tid == 0 ? __hip_atomic_fetch_add(head, 1u, RLX_AGENT) : 0u;
        conv_rows(p, l, c * CHUNK + tid, (c + 1) * CHUNK, NTHR);
        __syncthreads();
        if (tid == 0) *(volatile LAS int*)(lds + RING_OFF + at::OFF_Q) = (int)pre;
        __syncthreads();
        c = *(volatile LAS int*)(lds + RING_OFF + at::OFF_Q);
    }
}
PHFN void ph_attn_fox(LAS unsigned char* lds, const bf16* PROJ, const float* LOGF, bf16* MIX, unsigned* heads, const Ready& rd) {
    int cur = (int)(xb_xcc_id() & 7u);
    for (int idx = queue8_next(heads, 48, cur, lds, rd); idx >= 0; ) {
        unsigned pre = 0u;
        const int qb = 15 - idx / 3, b = cur >> 1, h = (cur & 1) * 3 + idx % 3; const size_t tok0 = (size_t)b * SEQ;
        at::attn_unit<0>((LAS char*)(lds + RING_OFF), PROJ + (tok0 + qb * 256) * INP + C_FQ + h * 128, INP, PROJ + tok0 * INP + C_FK + h * 128, PROJ + tok0 * INP + C_FV + h * 128, INP,
                         LOGF + (size_t)(b * NFH + h) * SEQ, qb * 256, 4 * (qb + 1), MIX + (tok0 + qb * 256) * D + h * 128, D, 0.f, nullptr, 0.f, heads + 64 * cur, pre);
        idx = queue8_take(pre, heads, 48, cur, lds, rd);
    }
}
PHFN void ph_attn_diff(LAS unsigned char* lds, const bf16* PROJ, bf16* MIX, unsigned* heads, const float* lq1, const float* lk1, const float* lq2, const float* lk2, const float* subg, int l, const Ready& rd) {
    const int lane = opaque_tid() & 63;
    const float lam_init = 0.8f - 0.6f * expf(-0.3f * (float)l);
    const float lam = expf(wave_sum(lq1[lane] * lk1[lane])) - expf(wave_sum(lq2[lane] * lk2[lane])) + lam_init;
    int cur = (int)(xb_xcc_id() & 7u);
    for (int idx = queue8_next(heads, 96, cur, lds, rd); idx >= 0; ) {
        unsigned pre = 0u;
        const int qb = 31 - idx / 3, b = cur >> 1, h = (cur & 1) * 3 + idx % 3; const size_t tok0 = (size_t)b * SEQ;
        at::attn_unit<1>((LAS char*)(lds + RING_OFF), PROJ + (tok0 + qb * 128) * INP + C_DQ + h * 128, INP, PROJ + tok0 * INP + C_DK + h * 128, PROJ + tok0 * INP + C_DV + h * 128, INP,
                         nullptr, qb * 128, 2 * (qb + 1), MIX + (tok0 + qb * 128) * D + 768 + h * 128, D, lam, subg, 1.0f - lam_init, heads + 64 * cur, pre);
        idx = queue8_take(pre, heads, 96, cur, lds, rd);
    }
}
PHFN void ph_attn_cross(LAS unsigned char* lds, const bf16* QC, const bf16* KVL  , bf16* OC) {
    for (int u = (int)blockIdx.x; u < 256; u += (int)gridDim.x) {
        const int pm = (u & 7) * 8 + ((u >> 3) & 7), h = u >> 6, b = pm >> 4; const size_t tok0 = (size_t)pm * 256; unsigned nopre = 0u;
        const bf16* kv = KVL + (size_t)(b * MEMLEN) * (2 * CRW) + h * 128;
        at::attn_unit<2>((LAS char*)(lds + RING_OFF), QC + tok0 * CRW + h * 128, CRW, kv, kv + CRW, 2 * CRW, nullptr, 0, MEMLEN / 64, OC + tok0 * CRW + h * 128, CRW, 0.f, nullptr, 0.f, nullptr, nopre);
    }
}

#ifndef PROBE_DUP
#define PROBE_DUP 0
#endif
constexpr int N_STEPS = 2 + 8 * 2 + DEPTH * 6 + 1;
__global__ void __launch_bounds__(NTHR, 2) fwd(Params p) {
    extern __shared__ __attribute__((aligned(16))) unsigned char lds_raw[];
    LAS unsigned char* lds = (LAS unsigned char*)lds_raw;
    const int tid = threadIdx.x;
    unsigned* ctl = (unsigned*)(p.ws + WS_CTL);
    for (int u = tid; u < (LDS_BYTES - LDSCTL_OFF) / 4; u += NTHR) ((LAS unsigned*)(lds + LDSCTL_OFF))[u] = 0u;
    __syncthreads();
    XcdBarrier bar; bar.bar = ctl + CW_BAR; bar.x = 0; bar.st = nullptr;
    if (p.s_hi - p.s_lo > 1) bar = xcd_barrier_post(ctl + CW_BAR, (volatile LAS unsigned*)(lds + MISC_OFF) + 8);
    if (tid == 0) __hip_atomic_store(ctl + CW_GXCC + blockIdx.x, xb_xcc_id() + 1u, __ATOMIC_RELAXED, __HIP_MEMORY_SCOPE_AGENT);
    const bool grouped = gridDim.x == 256 && p.s_hi - p.s_lo > 1;
    int cur = 0;
#if PROBE_DUP & 512
#define PH_ENDG  if (cur + 1 < p.s_hi) { if (grouped) { group_barrier(ctl, (volatile LAS unsigned*)(lds + MISC_OFF) + 10); group_barrier(ctl, (volatile LAS unsigned*)(lds + MISC_OFF) + 10); group_barrier(ctl, (volatile LAS unsigned*)(lds + MISC_OFF) + 10); } else xcd_barrier(bar); } } ++cur;
#elif PROBE_DUP & 16384
#define PH_ENDG  if (cur + 1 < p.s_hi) { __syncthreads(); const unsigned long long t0_ = wall_clock64(); if (grouped) group_barrier(ctl, (volatile LAS unsigned*)(lds + MISC_OFF) + 10); else xcd_barrier(bar); if (tid == 0) ((LAS unsigned*)(lds + MISC_OFF))[14] += (unsigned)(wall_clock64() - t0_); } } ++cur;
#else
#define PH_ENDG  if (cur + 1 < p.s_hi) { if (grouped) group_barrier(ctl, (volatile LAS unsigned*)(lds + MISC_OFF) + 10); else xcd_barrier(bar); } } ++cur;
#endif
#define PH_ENDB  if (cur + 1 < p.s_hi) { if (grouped) batch_post(ctl, (blockIdx.x & 7u) >> 1); else xcd_barrier(bar); } } ++cur;
#define PH_BEGIN if (p.s_lo <= cur && cur < p.s_hi) {
#if PROBE_DUP & 512
#define PH_END   if (cur + 1 < p.s_hi) { xcd_barrier(bar); xcd_barrier(bar); } } ++cur;
#elif PROBE_DUP & 16384
    int accw = 12;
#define PH_END   if (cur + 1 < p.s_hi) { __syncthreads(); const unsigned long long t0_ = wall_clock64(); xcd_barrier(bar); if (tid == 0) ((LAS unsigned*)(lds + MISC_OFF))[accw] += (unsigned)(wall_clock64() - t0_); accw = 12; } } ++cur;
#else
#define PH_END   if (cur + 1 < p.s_hi) xcd_barrier(bar); } ++cur;
#endif
    bf16* const HB = (bf16*)(p.ws + WS_NB); unsigned long long* ssq = (unsigned long long*)(p.ws + WS_SSQ);     bf16* const ACT = (bf16*)(p.ws + WS_ACT); bf16* const PROJ = (bf16*)(p.ws + WS_PROJ); bf16* const MIX = (bf16*)(p.ws + WS_MIX);
    bf16* const QC = (bf16*)(p.ws + WS_QC); bf16* const OC = (bf16*)(p.ws + WS_OC); bf16* const KVB = (bf16*)(p.ws + WS_KV);
    float* const LOGF = (float*)(p.ws + WS_LOGF);

    PH_BEGIN ph_prologue(p, lds);
#if PROBE_DUP & 2
        ph_prologue(p, lds);
#endif
    PH_END
    PH_BEGIN ph_gemm_kv(lds, (const bf16*)(p.ws + WS_MEMN), (const bf16*)(p.ws + WS_W + LW_KV), KVB); PH_END
    for (int j = 0; j < 2 * DEPTH; ++j) {
        const int l = j >> 1; const bool second = (j & 1) != 0;
        const unsigned char* wl = p.ws + WS_W + (size_t)l * LW_SIZE;
        PH_BEGIN
#if PROBE_DUP & 8192
            for (int rep = 0; rep < 2; ++rep)
                ph_gemm_swiglu(lds, HB, (const bf16*)(wl + (second ? LW_GU2 : LW_GU1)), rep ? PROJ : ACT, ssq, rep);
#elif PROBE_DUP & 4096
            for (int rep = 0; rep < 2; ++rep) {
                ph_gemm_swiglu(lds, HB, (const bf16*)(wl + (second ? LW_GU2 : LW_GU1)), ACT, ssq); if (rep == 0) xcd_barrier(bar); }
#else
            ph_gemm_swiglu(lds, HB, (const bf16*)(wl + (second ? LW_GU2 : LW_GU1)), ACT, ssq);
#endif
#if PROBE_DUP & 4
            ph_gemm_swiglu(lds, HB, (const bf16*)(wl + (second ? LW_GU2 : LW_GU1)), ACT, ssq);
#endif
        PH_ENDG
        PH_BEGIN ph_gemm_resid(lds, ACT, (const bf16*)(wl + (second ? LW_D2 : LW_D1)), FF, HB, ssq + M, 0.5f);
#if PROBE_DUP & 64
            ph_gemm_resid(lds, ACT, (const bf16*)(wl + (second ? LW_D2 : LW_D1)), FF, HB, (unsigned long long*)(p.ws + WS_SSQ) + 17 * (size_t)M, 0.0f);
#endif
        PH_ENDG
        ssq += M;
        if (!second) {
            PH_BEGIN
                ph_ff(HB, ssq, (const bf16*)(p.ws + WS_WFF) + (size_t)l * NFH * D, p.in[I_FBIAS] + l * NFH, LOGF, lds);
                ph_gemm_bf16(lds, HB, (const bf16*)(wl + LW_IN), INP, PROJ, ssq, (const float*)(p.ws + WS_ROPE));
#if PROBE_DUP & 16384
                accw = 15;
#endif
#if PROBE_DUP & 32
                ph_gemm_bf16(lds, HB, (const bf16*)(wl + LW_IN), INP, PROJ, ssq, (const float*)(p.ws + WS_ROPE));
#endif
            PH_ENDB
            const Ready rd{ctl, 64u * (unsigned)(l + 1), (volatile LAS unsigned*)(lds + MISC_OFF) + 16, grouped};
            PH_BEGIN
                ph_attn_fox(lds, PROJ, LOGF, MIX, ctl + CW_QUEUE + 512 * (3 * l), rd);
                ph_attn_diff(lds, PROJ, MIX, ctl + CW_QUEUE + 512 * (3 * l + 1), p.in[I_LQ1] + l * 64, p.in[I_LK1] + l * 64, p.in[I_LQ2] + l * 64, p.in[I_LK2] + l * 64, p.in[I_SUBLN] + l * 128, l, rd);
                ph_conv(p, l, ctl + CW_QUEUE + 512 * (3 * l) + 32, lds, rd);
#if PROBE_DUP & 16384
                accw = 13;
#endif
#if PROBE_DUP & 1
                ph_attn_fox(lds, PROJ, LOGF, MIX, ctl + CW_QUEUE + 512 * (12 + 3 * l), rd);
                ph_attn_diff(lds, PROJ, MIX, ctl + CW_QUEUE + 512 * (12 + 3 * l + 1), p.in[I_LQ1] + l * 64, p.in[I_LK1] + l * 64, p.in[I_LQ2] + l * 64, p.in[I_LK2] + l * 64, p.in[I_SUBLN] + l * 128, l, rd);
#endif
            PH_END
            PH_BEGIN ph_gemm_resid(lds, MIX, (const bf16*)(wl + LW_OUT), D, HB, ssq + M, 1.0f);
#if PROBE_DUP & 128
                ph_gemm_resid(lds, MIX, (const bf16*)(wl + LW_OUT), D, HB, (unsigned long long*)(p.ws + WS_SSQ) + 17 * (size_t)M, 0.0f);
#endif
            PH_ENDG
            ssq += M;
            PH_BEGIN ph_gemm_bf16(lds, HB, (const bf16*)(wl + LW_Q), CRW, QC, ssq, nullptr); PH_ENDG
            PH_BEGIN ph_attn_cross(lds, QC, KVB + (size_t)l * MMEM * 2 * CRW, OC);
#if PROBE_DUP & 16
                ph_attn_cross(lds, QC, KVB + (size_t)l * MMEM * 2 * CRW, OC);
#endif
            PH_ENDG
            PH_BEGIN ph_gemm_resid(lds, OC, (const bf16*)(wl + LW_O), CRW, HB, ssq + M, 1.0f);
#if PROBE_DUP & 256
                ph_gemm_resid(lds, OC, (const bf16*)(wl + LW_O), CRW, HB, (unsigned long long*)(p.ws + WS_SSQ) + 17 * (size_t)M, 0.0f);
#endif
            PH_ENDG
            ssq += M;
        }
    }
    PH_BEGIN ph_norm_out(HB, p.out, p.in[I_FINN]); PH_END
#if PROBE_DUP & 16384
    {   xcd_barrier(bar); unsigned* st = ctl + 8960;
        if (tid == 0) { const unsigned g = ((LAS unsigned*)(lds + MISC_OFF))[12], a = ((LAS unsigned*)(lds + MISC_OFF))[13];
            atomicMax(st + 0, g); atomicMax(st + 1, ~g); atomicAdd(st + 2, g); atomicMax(st + 3, a); atomicMax(st + 4, ~a); atomicAdd(st + 5, a);
            const unsigned gg = ((LAS unsigned*)(lds + MISC_OFF))[14]; atomicAdd(st + 6, gg); atomicMax(st + 7, ~gg);
            atomicAdd(st + 16 + (xb_xcc_id() & 7u), ((LAS unsigned*)(lds + MISC_OFF))[15]); }
        xcd_barrier(bar);
        if (blockIdx.x == 0 && tid == 0) { const int sel = (PROBE_DUP >> 16) & 7;
            unsigned xmin = 0xffffffffu, xmax = 0u; for (int j = 0; j < 8; ++j) { const unsigned s = xb_ld(st + 16 + j) / 32u; xmin = s < xmin ? s : xmin; xmax = s > xmax ? s : xmax; }
            const int sel8 = (PROBE_DUP >> 19) & 3;
            const unsigned v = sel8 == 1 ? xmin : sel8 == 2 ? xmax : sel == 0 ? xb_ld(st + 0) : sel == 1 ? ~xb_ld(st + 1) : sel == 2 ? xb_ld(st + 2) / gridDim.x : sel == 3 ? xb_ld(st + 3) : sel == 4 ? ~xb_ld(st + 4) : sel == 5 ? xb_ld(st + 5) / gridDim.x : sel == 6 ? xb_ld(st + 6) / gridDim.x : ~xb_ld(st + 7);
            const unsigned long long t0 = wall_clock64(); while (wall_clock64() - t0 < 4ull * v) __builtin_amdgcn_s_sleep(8); } }
#endif
#undef PH_BEGIN
#undef PH_END
#undef PH_ENDG
#undef PH_ENDB
}

extern "C" void kernel_launch(void* const* d_in, const int* in_sizes, int n_in, void* d_out, int out_size, void* d_ws, size_t ws_size, hipStream_t stream) {
    static int grid = 0;
    if (grid == 0) {
        if (n_in != 28 || in_sizes[0] != M * D || out_size != M * D || ws_size < WS_END) { fprintf(stderr, "kernel_launch: unexpected problem: n_in %d in0 %d out %d ws %zu (need %zu)\n", n_in, n_in > 0 ? in_sizes[0] : -1, out_size, ws_size, (size_t)WS_END); grid = -1; return; }
        int dev = 0, cus = 0, per_cu = 0;
        if (hipGetDevice(&dev) != hipSuccess || hipDeviceGetAttribute(&cus, hipDeviceAttributeMultiprocessorCount, dev) != hipSuccess) { grid = -1; return; }
        if (hipFuncSetAttribute((const void*)fwd, hipFuncAttributeMaxDynamicSharedMemorySize, LDS_BYTES) != hipSuccess) { fprintf(stderr, "kernel_launch: hipFuncSetAttribute failed\n"); grid = -1; return; }
        if (hipOccupancyMaxActiveBlocksPerMultiprocessor(&per_cu, (const void*)fwd, NTHR, LDS_BYTES) != hipSuccess || per_cu < 1) fprintf(stderr, "kernel_launch: occupancy query reports %d\n", per_cu);
        (void)hipGetLastError();
        grid = cus;
    }
    if (grid < 0) return;
    (void)hipMemsetAsync((char*)d_ws + WS_CTL, 0, CTL_ZERO_BYTES, stream);
    Params a{};
    for (int i = 0; i < 28; ++i) a.in[i] = (const float*)d_in[i];
    a.out = (float*)d_out; a.ws = (unsigned char*)d_ws;
#if MK_ONE_LAUNCH
    a.s_lo = 0; a.s_hi = N_STEPS;
    hipLaunchKernelGGL(fwd, dim3(grid), dim3(NTHR), LDS_BYTES, stream, a);
#else
    for (int s = 0; s < N_STEPS; ++s) { a.s_lo = s; a.s_hi = s + 1; hipLaunchKernelGGL(fwd, dim3(grid), dim3(NTHR), LDS_BYTES, stream, a); }
#endif
}
```

```cpp
#include <hip/hip_runtime.h>
#include <hip/hip_bf16.h>
#include <cstdio>
#include <cstdint>

#ifndef MK_ONE_LAUNCH
#define MK_ONE_LAUNCH 1
#endif
__device__ __forceinline__ int opaque_tid() { int t = (int)threadIdx.x; asm volatile("" : "+v"(t)); return t; }
namespace pg8 {
#define PG8_LAS __attribute__((address_space(3)))
typedef unsigned short bf16_t;
typedef short bf16x8 __attribute__((ext_vector_type(8)));
typedef float f32x4 __attribute__((ext_vector_type(4)));
typedef unsigned u32x4 __attribute__((ext_vector_type(4)));
constexpr int BM = 256, BK = 64, HALF = 128, HTB = HALF * BK * 2  , STAGE_BYTES = 8 * HTB, NXCD = 8, WGM = 8;

__host__ __device__ __forceinline__ int lds_byte(int r, int c) { const int st = (r >> 4) * 2 + (c >> 5), rr = r & 15, cc = c & 31, ob = rr * 64 + cc * 2; return st * 1024 + (ob ^ (((ob >> 9) & 1) << 5)); }
__host__ __device__ __forceinline__ void stage_rc(int b, int& R, int& C) { const int st = b / 1024, sb = b % 1024, swz = sb ^ (((sb >> 9) & 1) << 5); R = (st >> 1) * 16 + swz / 64; C = (st & 1) * 32 + (swz % 64) / 2; }
__host__ __device__ __forceinline__ int perm32(int rho) { const int n = rho >> 4, i = rho & 15; return 8 * (i >> 2) + 4 * n + (i & 3); }

struct Unit { int pm, pn; };
struct Gemm { const bf16_t* A; const bf16_t* Bt; int M, N, K; };

struct StaticOrder {
    int nM, nN, nwg, G, c, fixedp;
    __host__ __device__ void init(int M, int N, int G_, int c_) { nM = M / BM; nN = N / BM; nwg = nM * nN; G = G_; c = c_; fixedp = 0; }
    __host__ __device__ bool next(int i, Unit& u) const {
        const long L = (long)i * G + c; if (L >= nwg) return false;
        int wgid = (int)L; { const int q = nwg / NXCD, r = nwg % NXCD, xcd = wgid % NXCD, off = wgid / NXCD; wgid = (xcd < r ? xcd * (q + 1) : r * (q + 1) + (xcd - r) * q) + off; }
        const int nig = WGM * nN, gid = wgid / nig, fm = gid * WGM, gsz = (nM - fm) < WGM ? (nM - fm) : WGM;
        u.pm = fm + ((wgid % nig) % gsz); u.pn = (wgid % nig) / gsz; return true;
    }
    __device__ __forceinline__ void a_ready(const Unit&) const {}
    __device__ __forceinline__ void done(const Unit&) const {}
    __device__ __forceinline__ const char* aptr(const Gemm& g, const Unit& u, size_t tstep) const { return (const char*)g.A + (fixedp ? (size_t)0 : (size_t)u.pm * tstep); }
    __device__ __forceinline__ const char* bptr(const Gemm& g, const Unit& u, size_t tstep) const { return (const char*)g.Bt + (fixedp ? (size_t)0 : (size_t)u.pn * tstep); }
};

__device__ __forceinline__ unsigned cvt_pk_bf16(float lo, float hi) { unsigned r; asm volatile("v_cvt_pk_bf16_f32 %0, %1, %2" : "=v"(r) : "v"(lo), "v"(hi)); return r; }
typedef float f32x2 __attribute__((ext_vector_type(2)));

constexpr float SSQ_FIX = 1048576.0f, SSQ_UNFIX = 1.0f / 1048576.0f;
struct RowScale {
    const unsigned long long* ssq; PG8_LAS float* rs;
    __device__ __forceinline__ unsigned long long rs_load(int pm, int tid) const { return (ssq && tid < BM) ? ssq[pm * BM + tid] : 0ull; }
    __device__ __forceinline__ void rs_store(unsigned long long v, int par, int tid) const { if (tid < BM) rs[(par & 1) * BM + tid] = ssq ? __builtin_amdgcn_rsqf((float)v * (SSQ_UNFIX / 2048.0f) + 1e-6f) : 1.0f; }
    __device__ __forceinline__ void get(int ui, int wr, int fr, float (&r)[2][4]) const {
#pragma unroll
        for (int ai = 0; ai < 2; ++ai)
#pragma unroll
            for (int m = 0; m < 4; ++m) r[ai][m] = rs[(ui & 1) * BM + ai * HALF + wr * 64 + m * 16 + fr]; }
};
struct EpiBf16 : RowScale {
    static constexpr bool PERM = true, AFTER_DRAIN = false, ROWSCALE = true;
    bf16_t* O; int ldc; const float* rope; int rope_lo, rope_hi;
    __device__ __forceinline__ void operator()(const f32x4 (&acc)[2][2][4][2], const Unit& u, int wr, int wc, int fr, int fq, int ui) const {
        const int row0 = u.pm * BM + wr * 64 + fr; const int col0 = u.pn * BM + wc * 32 + 8 * fq;
        float rsv[2][4]; get(ui, wr, fr, rsv);
        const bool rot = rope != nullptr && u.pn >= rope_lo && u.pn < rope_hi && (wc & 1) == 0;
#pragma unroll
        for (int ai = 0; ai < 2; ++ai)
#pragma unroll
            for (int m = 0; m < 4; ++m) { const int row = row0 + ai * HALF + m * 16; bf16_t* rowp = O + (size_t)row * ldc + col0; const float r = rsv[ai][m];
                f32x4 cs0 = {1.f, 1.f, 1.f, 1.f}, cs1 = cs0, sn0 = {0.f, 0.f, 0.f, 0.f}, sn1 = sn0;
                if (rot) { const f32x4* tr = (const f32x4*)(rope + (size_t)row * 16); cs0 = tr[0]; cs1 = tr[1]; sn0 = tr[2]; sn1 = tr[3];
                    if (fq == 0) { sn0 = -sn0; sn1 = -sn1; } else if (fq > 1) { cs0 = (f32x4){1.f, 1.f, 1.f, 1.f}; cs1 = cs0; sn0 = (f32x4){0.f, 0.f, 0.f, 0.f}; sn1 = sn0; } }
#pragma unroll
                for (int bj = 0; bj < 2; ++bj) { f32x4 v0 = acc[ai][bj][m][0] * r, v1 = acc[ai][bj][m][1] * r;
                    if (rot) { f32x4 p0, p1;
#pragma unroll
                        for (int e = 0; e < 4; ++e) { p0[e] = __shfl_xor(v0[e], 16); p1[e] = __shfl_xor(v1[e], 16); }
                        v0 = v0 * cs0 + p0 * sn0; v1 = v1 * cs1 + p1 * sn1; }
                    u32x4 w; w.x = cvt_pk_bf16(v0[0], v0[1]); w.y = cvt_pk_bf16(v0[2], v0[3]); w.z = cvt_pk_bf16(v1[0], v1[1]); w.w = cvt_pk_bf16(v1[2], v1[3]);
                    *(u32x4*)(rowp + bj * HALF) = w; } }
    }
};
__device__ __forceinline__ float silu_mul(float g, float u) { return g * u * __builtin_amdgcn_rcpf(1.0f + __builtin_amdgcn_exp2f(-1.4426950408889634f * g)); }
struct EpiSwiglu : RowScale {
    static constexpr bool PERM = true, AFTER_DRAIN = false, ROWSCALE = true;
    bf16_t* O; int ldc;
    __device__ __forceinline__ void operator()(const f32x4 (&acc)[2][2][4][2], const Unit& u, int wr, int wc, int fr, int fq, int ui) const {
        const int row0 = u.pm * BM + wr * 64 + fr; const int col0 = u.pn * HALF + wc * 32 + 8 * fq;
        float rsv[2][4]; get(ui, wr, fr, rsv);
#pragma unroll
        for (int ai = 0; ai < 2; ++ai)
#pragma unroll
            for (int m = 0; m < 4; ++m) { bf16_t* rowp = O + (size_t)(row0 + ai * HALF + m * 16) * ldc + col0; const float r = rsv[ai][m];
                const f32x4 g0 = acc[ai][0][m][0] * r, g1 = acc[ai][0][m][1] * r, u0 = acc[ai][1][m][0] * r, u1 = acc[ai][1][m][1] * r;
                u32x4 w; w.x = cvt_pk_bf16(silu_mul(g0[0], u0[0]), silu_mul(g0[1], u0[1])); w.y = cvt_pk_bf16(silu_mul(g0[2], u0[2]), silu_mul(g0[3], u0[3]));
                w.z = cvt_pk_bf16(silu_mul(g1[0], u1[0]), silu_mul(g1[1], u1[1])); w.w = cvt_pk_bf16(silu_mul(g1[2], u1[2]), silu_mul(g1[3], u1[3]));
                *(u32x4*)rowp = w; }
    }
};
__device__ __forceinline__ float bfl(unsigned w) { return __builtin_bit_cast(float, w << 16); }
__device__ __forceinline__ float bfh(unsigned w) { return __builtin_bit_cast(float, w & 0xffff0000u); }
struct EpiResid {
    static constexpr bool PERM = true, AFTER_DRAIN = false, ROWSCALE = false;
    bf16_t* hb; unsigned long long* ssq; int ldc; float s; PG8_LAS float* red;
    __device__ __forceinline__ void operator()(const f32x4 (&acc)[2][2][4][2], const Unit& u, int wr, int wc, int fr, int fq, int) const {
        const int row0 = u.pm * BM + wr * 64 + fr; const int col0 = u.pn * BM + wc * 32 + 8 * fq;
        u32x4 pre[8][2];
#pragma unroll
        for (int g = 0; g < 8; ++g) { const size_t off = (size_t)(row0 + (g >> 2) * HALF + (g & 3) * 16) * ldc + col0;
#pragma unroll
            for (int bj = 0; bj < 2; ++bj) pre[g][bj] = *(const u32x4*)(hb + off + bj * HALF); }
#pragma unroll
        for (int g = 0; g < 8; ++g) { const int ai = g >> 2, m = g & 3; const size_t off = (size_t)(row0 + ai * HALF + m * 16) * ldc + col0; float q = 0.f;
#pragma unroll
            for (int bj = 0; bj < 2; ++bj) { const u32x4 b = pre[g][bj];
                const f32x4 v0 = (f32x4){bfl(b.x), bfh(b.x), bfl(b.y), bfh(b.y)} + acc[ai][bj][m][0] * s, v1 = (f32x4){bfl(b.z), bfh(b.z), bfl(b.w), bfh(b.w)} + acc[ai][bj][m][1] * s;
                u32x4 w; w.x = cvt_pk_bf16(v0[0], v0[1]); w.y = cvt_pk_bf16(v0[2], v0[3]); w.z = cvt_pk_bf16(v1[0], v1[1]); w.w = cvt_pk_bf16(v1[2], v1[3]);
                *(u32x4*)(hb + off + bj * HALF) = w;
                q += (v0[0] * v0[0] + v0[1] * v0[1]) + (v0[2] * v0[2] + v0[3] * v0[3]) + (v1[0] * v1[0] + v1[1] * v1[1]) + (v1[2] * v1[2] + v1[3] * v1[3]); }
            { auto r16 = __builtin_amdgcn_permlane16_swap(__float_as_uint(q), __float_as_uint(q), false, false); q = __uint_as_float(r16[0]) + __uint_as_float(r16[1]);
              auto r32 = __builtin_amdgcn_permlane32_swap(__float_as_uint(q), __float_as_uint(q), false, false); q = __uint_as_float(r32[0]) + __uint_as_float(r32[1]); }
            if (fq == 0) red[wc * BM + ai * HALF + wr * 64 + m * 16 + fr] = q; }
        asm volatile("s_waitcnt lgkmcnt(0)" ::: "memory"); __builtin_amdgcn_s_barrier(); asm volatile("" ::: "memory");
        const int t = wr * 256 + wc * 64 + fq * 16 + fr;
        if (t < BM) { const float sum = (red[t] + red[BM + t]) + (red[2 * BM + t] + red[3 * BM + t]);
            (void)__hip_atomic_fetch_add(ssq + u.pm * BM + t, (unsigned long long)(sum * SSQ_FIX), __ATOMIC_RELAXED, __HIP_MEMORY_SCOPE_AGENT); }
        asm volatile("s_waitcnt lgkmcnt(0)" ::: "memory"); __builtin_amdgcn_s_barrier(); asm volatile("" ::: "memory");
    }
};
template <class Epi, class Sched, bool ALIGN_EPI = false, bool SP2 = false>
__device__ __forceinline__ void gemm_phase(PG8_LAS unsigned char* lds, const Gemm g, const Sched& S, const Epi& E) {
    const int tid = opaque_tid(), wid = __builtin_amdgcn_readfirstlane(tid >> 6), lane = tid & 63, wr = wid >> 2, wc = wid & 3, fr = lane & 15, fq = lane >> 4;
    const int K = g.K, nt = K / BK;
    unsigned voffA[2], voffB[2];
#pragma unroll
    for (int i = 0; i < 2; ++i) { int R, C; stage_rc(tid * 16 + i * 8192, R, C); const int Rb = Epi::PERM ? ((R & ~31) + perm32(R & 31)) : R;
        voffA[i] = (unsigned)(R * K + C) * 2u; voffB[i] = (unsigned)(Rb * K + C) * 2u; }
    const size_t kstep = (size_t)(BK * 2);
    const size_t hstep = (size_t)HALF * K * 2;
    const size_t tstep = 2 * hstep;
    const unsigned ldsw = (unsigned)wid * 1024u;
    const int aoff = lds_byte(wr * 64 + fr, fq * 8), boff = lds_byte(wc * 32 + fr, fq * 8);
#define PG8_SA(b, h) (((b) * 2 + (h)) * HTB)
#define PG8_SB(b, h) ((4 + (b) * 2 + (h)) * HTB)
#define PG8_STAGE(bufoff, gbase, voff) do { _Pragma("unroll") for (int _i = 0; _i < 2; ++_i) \
        __builtin_amdgcn_global_load_lds((const unsigned*)((const char*)(gbase) + (voff)[_i]), (PG8_LAS unsigned*)(lds + (bufoff) + ldsw + _i * 8192), 16, 0, 0); } while (0)
#define PG8_LDA(dst, b, h) do { _Pragma("unroll") for (int m = 0; m < 4; ++m) _Pragma("unroll") for (int k = 0; k < 2; ++k) dst[m][k] = *(const PG8_LAS bf16x8*)(lds + PG8_SA(b, h) + aoff + m * 2048 + k * 1024); } while (0)
#define PG8_LDB(dst, b, h) do { _Pragma("unroll") for (int n = 0; n < 2; ++n) _Pragma("unroll") for (int k = 0; k < 2; ++k) dst[n][k] = *(const PG8_LAS bf16x8*)(lds + PG8_SB(b, h) + boff + n * 2048 + k * 1024); } while (0)
#define PG8_MMA(ai, bj, At, Bt) do { __builtin_amdgcn_s_setprio(1); _Pragma("unroll") for (int m = 0; m < 4; ++m) _Pragma("unroll") for (int n = 0; n < 2; ++n) _Pragma("unroll") for (int k = 0; k < 2; ++k) \
        acc[ai][bj][m][n] = __builtin_amdgcn_mfma_f32_16x16x32_bf16(Bt[n][k], At[m][k], acc[ai][bj][m][n], 0, 0, 0); __builtin_amdgcn_s_setprio(0); } while (0)
#define PG8_WAIT_V(n) asm volatile("s_waitcnt vmcnt(" #n ")" ::: "memory")
#define PG8_WAIT_L(n) asm volatile("s_waitcnt lgkmcnt(" #n ")" ::: "memory")
#define PG8_BAR __builtin_amdgcn_s_barrier()
#define PG8_SCHED __builtin_amdgcn_sched_barrier(0)
    Unit cur, nxt; int ui = 0;
    if (!S.next(0, cur)) return;
    f32x4 acc[2][2][4][2];
#pragma unroll
    for (int a = 0; a < 2; ++a)
#pragma unroll
        for (int b = 0; b < 2; ++b)
#pragma unroll
            for (int m = 0; m < 4; ++m)
#pragma unroll
                for (int n = 0; n < 2; ++n) acc[a][b][m][n] = (f32x4){0.f, 0.f, 0.f, 0.f};
    bf16x8 At[4][2], B0[2][2], B1[2][2];
    const char* cA = S.aptr(g, cur, tstep); const char* cB = S.bptr(g, cur, tstep);
    S.a_ready(cur);
    if constexpr (Epi::ROWSCALE) E.rs_store(E.rs_load(cur.pm, tid), 0, tid);
    if constexpr (SP2) {
        PG8_STAGE(PG8_SB(0, 0), cB, voffB); PG8_STAGE(PG8_SB(0, 1), cB + hstep, voffB); PG8_STAGE(PG8_SA(0, 0), cA, voffA); PG8_STAGE(PG8_SA(0, 1), cA + hstep, voffA);
        if (wr == 1) PG8_BAR;
        PG8_WAIT_V(2); PG8_BAR;
        PG8_STAGE(PG8_SB(1, 0), cB + kstep, voffB); PG8_STAGE(PG8_SA(1, 0), cA + kstep, voffA); PG8_STAGE(PG8_SB(1, 1), cB + hstep + kstep, voffB);
        PG8_WAIT_V(6); PG8_BAR;
    } else {
        PG8_STAGE(PG8_SB(0, 0), cB, voffB); PG8_STAGE(PG8_SA(0, 0), cA, voffA); PG8_STAGE(PG8_SB(0, 1), cB + hstep, voffB); PG8_STAGE(PG8_SA(0, 1), cA + hstep, voffA);
        if (wr == 1) PG8_BAR;
        PG8_WAIT_V(4); PG8_BAR;
        PG8_STAGE(PG8_SB(1, 0), cB + kstep, voffB); PG8_STAGE(PG8_SA(1, 0), cA + kstep, voffA); PG8_STAGE(PG8_SB(1, 1), cB + hstep + kstep, voffB);
        PG8_WAIT_V(6); PG8_BAR;
    }
    for (;;) {
        const bool has_next = S.next(ui + 1, nxt);
        const char* nA = has_next ? S.aptr(g, nxt, tstep) : cA; const char* nB = has_next ? S.bptr(g, nxt, tstep) : cB;
        for (int t = 0; t < nt; t += 2) {
            const bool last = (t == nt - 2);
            const char* a1 = cA + (size_t)(t + 1) * kstep;
            const char* a2 = last ? nA : cA + (size_t)(t + 2) * kstep; const char* b2 = last ? nB : cB + (size_t)(t + 2) * kstep;
            const char* a3 = a2 + kstep; const char* b3 = b2 + kstep;
            if (last && has_next) S.a_ready(nxt);
            if constexpr (SP2) {
            PG8_LDB(B0, 0, 0); PG8_LDB(B1, 0, 1); PG8_SCHED; PG8_LDA(At, 0, 0); PG8_STAGE(PG8_SA(1, 1), a1 + hstep, voffA);
            PG8_WAIT_V(8); PG8_WAIT_L(0); PG8_BAR; PG8_MMA(0, 0, At, B0); PG8_MMA(0, 1, At, B1); PG8_BAR; PG8_SCHED;
            PG8_LDA(At, 0, 1); PG8_STAGE(PG8_SB(0, 0), b2, voffB); PG8_STAGE(PG8_SB(0, 1), b2 + hstep, voffB); PG8_STAGE(PG8_SA(0, 0), a2, voffA);
            PG8_WAIT_V(8); PG8_WAIT_L(0); PG8_BAR; PG8_MMA(1, 0, At, B0); PG8_MMA(1, 1, At, B1); PG8_BAR; PG8_SCHED;
            PG8_LDB(B0, 1, 0); PG8_LDB(B1, 1, 1); PG8_SCHED; PG8_LDA(At, 1, 0); PG8_STAGE(PG8_SA(0, 1), a2 + hstep, voffA);
            PG8_WAIT_V(8); PG8_WAIT_L(0); PG8_BAR; PG8_MMA(0, 0, At, B0); PG8_MMA(0, 1, At, B1); PG8_BAR; PG8_SCHED;
            PG8_LDA(At, 1, 1); PG8_STAGE(PG8_SB(1, 0), b3, voffB); PG8_STAGE(PG8_SB(1, 1), b3 + hstep, voffB); PG8_STAGE(PG8_SA(1, 0), a3, voffA);
            PG8_WAIT_V(8); PG8_WAIT_L(0); PG8_BAR; PG8_MMA(1, 0, At, B0); PG8_MMA(1, 1, At, B1); PG8_BAR; PG8_SCHED;
            } else {
            PG8_LDB(B0, 0, 0); PG8_SCHED; PG8_LDA(At, 0, 0); PG8_STAGE(PG8_SA(1, 1), a1 + hstep, voffA);
            PG8_WAIT_L(8); PG8_BAR; PG8_WAIT_L(0); PG8_MMA(0, 0, At, B0); PG8_BAR; PG8_SCHED;
            PG8_LDB(B1, 0, 1); PG8_STAGE(PG8_SB(0, 0), b2, voffB);
            PG8_BAR; PG8_WAIT_L(0); PG8_MMA(0, 1, At, B1); PG8_BAR;
            PG8_LDA(At, 0, 1); PG8_STAGE(PG8_SA(0, 0), a2, voffA);
            PG8_BAR; PG8_WAIT_L(0); PG8_MMA(1, 0, At, B0); PG8_BAR; PG8_SCHED;
            PG8_STAGE(PG8_SB(0, 1), b2 + hstep, voffB);
            PG8_WAIT_V(6); PG8_BAR; PG8_MMA(1, 1, At, B1); PG8_BAR;
            PG8_LDB(B0, 1, 0); PG8_SCHED; PG8_LDA(At, 1, 0); PG8_STAGE(PG8_SA(0, 1), a2 + hstep, voffA);
            PG8_WAIT_L(8); PG8_BAR; PG8_WAIT_L(0); PG8_MMA(0, 0, At, B0); PG8_BAR; PG8_SCHED;
            PG8_LDB(B1, 1, 1); PG8_STAGE(PG8_SB(1, 0), b3, voffB);
            PG8_BAR; PG8_WAIT_L(0); PG8_MMA(0, 1, At, B1); PG8_BAR;
            PG8_LDA(At, 1, 1); PG8_STAGE(PG8_SA(1, 0), a3, voffA);
            PG8_BAR; PG8_WAIT_L(0); PG8_MMA(1, 0, At, B0); PG8_BAR; PG8_SCHED;
            PG8_STAGE(PG8_SB(1, 1), b3 + hstep, voffB);
            PG8_WAIT_V(6); PG8_BAR; PG8_MMA(1, 1, At, B1); PG8_BAR;
            }
        }
        if constexpr (ALIGN_EPI) { if (wr == 0) PG8_BAR; }
        if constexpr (!Epi::AFTER_DRAIN) {
            unsigned long long pend_ = 0ull; if constexpr (Epi::ROWSCALE) pend_ = E.rs_load(has_next ? nxt.pm : cur.pm, tid);
            E(acc, cur, wr, wc, fr, fq, ui);
            if constexpr (Epi::ROWSCALE) E.rs_store(pend_, ui + 1, tid);
            S.done(cur); }
        if (!has_next) break;
#pragma unroll
        for (int a = 0; a < 2; ++a)
#pragma unroll
            for (int b = 0; b < 2; ++b)
#pragma unroll
                for (int m = 0; m < 4; ++m)
#pragma unroll
                    for (int n = 0; n < 2; ++n) acc[a][b][m][n] = (f32x4){0.f, 0.f, 0.f, 0.f};
        cur = nxt; cA = nA; cB = nB; ++ui;
        if constexpr (ALIGN_EPI) { if (wr == 1) PG8_BAR; }
    }
    PG8_WAIT_V(0);
    if constexpr (!ALIGN_EPI) { if (wr == 0) PG8_BAR; }
    PG8_BAR;
    if constexpr (Epi::AFTER_DRAIN) { E.fused(acc, cur, wr, wc, fr, fq, lds, wid, lane); S.done(cur); }
#undef PG8_SA
#undef PG8_SB
#undef PG8_STAGE
#undef PG8_LDA
#undef PG8_LDB
#undef PG8_MMA
#undef PG8_WAIT_V
#undef PG8_WAIT_L
#undef PG8_BAR
#undef PG8_SCHED
}
}

namespace at {
#define AT_LAS __attribute__((address_space(3)))
typedef unsigned short bf16_t;
typedef short bf16x8 __attribute__((ext_vector_type(8)));
typedef short s16x4 __attribute__((ext_vector_type(4)));
typedef float f32x16 __attribute__((ext_vector_type(16)));
typedef float f32x4 __attribute__((ext_vector_type(4)));
typedef unsigned u32x4 __attribute__((ext_vector_type(4)));
constexpr int KVBLK = 64, SHM_V = 16384, SHM_K = 16384;
constexpr int OFF_V = 0, OFF_K = 2 * SHM_V, OFF_BIAS = OFF_K + 2 * SHM_K, OFF_WS = OFF_BIAS + 1024  , OFF_Q = OFF_WS + 8 * 256, OFF_X = 0  , ATT_LDS = OFF_Q + 256;
static_assert(4 * 32 * 128 * 4 <= OFF_BIAS, "exchange fits the tile buffers");
constexpr float THR = 8.f;
#ifdef PROBE_DUP
constexpr bool AT_PROBE_MFMA2 = (PROBE_DUP & 1024) != 0, AT_PROBE_VALU = (PROBE_DUP & 2048) != 0, AT_PROBE_BAR = (PROBE_DUP & 32768) != 0;
#else
constexpr bool AT_PROBE_MFMA2 = false, AT_PROBE_VALU = false, AT_PROBE_BAR = false;
#endif

#define KSWZ(row, colB) ((row) * 256 + ((colB) ^ (((row) & 7) << 4)))
#define SBAR() __builtin_amdgcn_sched_barrier(0)
__device__ __forceinline__ int v_st(int k, int c) { const int kk = (k & ~0xC) | ((k & 4) << 1) | ((k & 8) >> 1); return ((kk >> 3) * 4 + (c >> 5)) * 512 + ((kk & 7) * 32 + (c & 31)) * 2; }
__device__ __forceinline__ int v_rd_base(int lane) { return ((lane & 3) << 3) | (((lane >> 2) & 3) << 6) | (((lane >> 4) & 1) << 5) | (((lane >> 5) & 1) << 8); }
constexpr int v_rd_off(int d0, int ks, int half) { return d0 * 512 + ks * 4096 + half * 2048; }
__device__ __forceinline__ int crow(int r, int hi) { return (r & 3) + 8 * (r >> 2) + 4 * hi; }
__device__ __forceinline__ unsigned cvtpk(float lo, float hi) { unsigned r; asm volatile("v_cvt_pk_bf16_f32 %0, %1, %2" : "=v"(r) : "v"(lo), "v"(hi)); return r; }

template <int CTRL> __device__ __forceinline__ float dppf(float v) { return __builtin_bit_cast(float, __builtin_amdgcn_update_dpp(0, __builtin_bit_cast(int, v), CTRL, 0xF, 0xF, true)); }
__device__ __forceinline__ float lane_xor1(float v) { return dppf<0xB1>(v); }
__device__ __forceinline__ float sum32(float s) {
    s += dppf<0xB1>(s); s += dppf<0x4E>(s);
    s += dppf<0x141>(s); s += dppf<0x140>(s);
    s += __shfl_xor(s, 16); return s; }
template <int CTRL, int RMASK> __device__ __forceinline__ float dpp0(float v) { return __builtin_bit_cast(float, __builtin_amdgcn_update_dpp(0, __builtin_bit_cast(int, v), CTRL, RMASK, 0xF, false)); }
__device__ __forceinline__ float wave_incl_scan(float x) {
    x += dpp0<0x111, 0xF>(x); x += dpp0<0x112, 0xF>(x); x += dpp0<0x114, 0xF>(x); x += dpp0<0x118, 0xF>(x);
    x += dpp0<0x142, 0xA>(x);
    x += dpp0<0x143, 0xC>(x);
    return x;
}
__device__ __forceinline__ void mask_tile(f32x16& p0, f32x16& p1, int dq, unsigned W) {
    const float NEG = -__builtin_inff();
#pragma unroll
    for (int r = 0; r < 16; ++r) {
        const int c = (r & 3) + 8 * (r >> 2);
        if ((unsigned)(dq - c) >= W) p0[r] = NEG;
        if ((unsigned)(dq - c - 32) >= W) p1[r] = NEG;
    }
}
template <int SCI> struct ScaleOf { static constexpr float v = SCI == 64 ? 0.125f : 0.08838834764831845f; };
template <int SCI>
__device__ __forceinline__ void partialSM(f32x16& p0, f32x16& p1, float& m_reg, float& mn, float& alpha) {
    constexpr float SCALE = ScaleOf<SCI>::v;
    float pmax = p0[0];
#pragma unroll
    for (int r = 1; r < 16; ++r) pmax = fmaxf(pmax, p0[r]);
#pragma unroll
    for (int r = 0; r < 16; ++r) pmax = fmaxf(pmax, p1[r]);
    { auto rr = __builtin_amdgcn_permlane32_swap(__float_as_uint(pmax), __float_as_uint(pmax), false, false);
      pmax = fmaxf(__uint_as_float(rr[0]), __uint_as_float(rr[1])); }
    constexpr float C2 = 1.4426950408889634f * SCALE;
    if (__builtin_expect(__all((pmax - m_reg) * SCALE <= THR), 1)) { mn = m_reg; alpha = 1.f; }
    else { mn = fmaxf(m_reg, pmax); alpha = __builtin_amdgcn_exp2f((m_reg - mn) * C2); m_reg = mn; }
    const float mnL = -mn * C2;
#pragma unroll
    for (int r = 0; r < 16; ++r) p0[r] = fmaf(p0[r], C2, mnL);
#pragma unroll
    for (int r = 0; r < 16; ++r) p1[r] = fmaf(p1[r], C2, mnL);
#pragma unroll
    for (int r = 0; r < 16; ++r) p0[r] = __builtin_amdgcn_exp2f(p0[r]);
}
__device__ __forceinline__ void finishSM(f32x16& p0, f32x16& p1, float alpha, float& l_reg, bf16x8& pa0, bf16x8& pa1, bf16x8& pa2, bf16x8& pa3) {
#pragma unroll
    for (int r = 0; r < 16; ++r) p1[r] = __builtin_amdgcn_exp2f(p1[r]);
    float ps = 0;
#pragma unroll
    for (int r = 0; r < 16; ++r) ps += p0[r];
#pragma unroll
    for (int r = 0; r < 16; ++r) ps += p1[r];
    { auto rr = __builtin_amdgcn_permlane32_swap(__float_as_uint(ps), __float_as_uint(ps), false, false);
      ps = __uint_as_float(rr[0]) + __uint_as_float(rr[1]); }
    l_reg = l_reg * alpha + ps;
#define PK4(P, B_, OUT) do { unsigned a0 = cvtpk(P[B_+0], P[B_+1]), a1 = cvtpk(P[B_+2], P[B_+3]);                          \
        unsigned b0 = cvtpk(P[B_+4], P[B_+5]), b1 = cvtpk(P[B_+6], P[B_+7]);                                             \
        auto r0 = __builtin_amdgcn_permlane32_swap(a0, b0, false, false); auto r1 = __builtin_amdgcn_permlane32_swap(a1, b1, false, false); \
        u32x4 w = {r0[0], r1[0], r0[1], r1[1]}; OUT = *reinterpret_cast<bf16x8*>(&w); } while (0)
    PK4(p0, 0, pa0); PK4(p0, 8, pa1); PK4(p1, 0, pa2); PK4(p1, 8, pa3);
#undef PK4
}
template <int NK, int KB>
__device__ __forceinline__ void qkt(f32x16& p0, f32x16& p1, const AT_LAS char* K_lds, int r32, int hi, const bf16x8* qr) {
    p0 = f32x16{}; p1 = f32x16{};
    const AT_LAS char* kb[4];
#pragma unroll
    for (int dd = 0; dd < 4; ++dd) kb[dd] = K_lds + KB * SHM_K + KSWZ(r32, (dd * 16 + hi * 8) * 2);
#pragma unroll
    for (int d0 = 0; d0 < NK; ++d0) { const AT_LAS char* a = kb[d0 & 3] + (d0 >> 2) * 128;
        const bf16x8 b0 = *reinterpret_cast<const AT_LAS bf16x8*>(a);
        const bf16x8 b1 = *reinterpret_cast<const AT_LAS bf16x8*>(a + 32 * 256);
        p0 = __builtin_amdgcn_mfma_f32_32x32x16_bf16(b0, qr[d0], p0, 0, 0, 0);
        p1 = __builtin_amdgcn_mfma_f32_32x32x16_bf16(b1, qr[d0], p1, 0, 0, 0); }
}
template <int D0, int KB>
__device__ __forceinline__ void qkt_load4(bf16x8 (&kf)[8], const AT_LAS char* K_lds, int r32, int hi) {
#pragma unroll
    for (int dd = 0; dd < 4; ++dd) { const AT_LAS char* a = K_lds + KB * SHM_K + KSWZ(r32, (dd * 16 + hi * 8) * 2) + (D0 >> 2) * 128;
        kf[2 * dd] = *reinterpret_cast<const AT_LAS bf16x8*>(a); kf[2 * dd + 1] = *reinterpret_cast<const AT_LAS bf16x8*>(a + 32 * 256); }
}
template <int D0>
__device__ __forceinline__ void qkt_mfma4(f32x16& p0, f32x16& p1, const bf16x8 (&kf)[8], const bf16x8* qr) {
#pragma unroll
    for (int dd = 0; dd < 4; ++dd) {
        p0 = __builtin_amdgcn_mfma_f32_32x32x16_bf16(kf[2 * dd], qr[D0 + dd], p0, 0, 0, 0);
        p1 = __builtin_amdgcn_mfma_f32_32x32x16_bf16(kf[2 * dd + 1], qr[D0 + dd], p1, 0, 0, 0); }
}
template <int VB>
__device__ __forceinline__ void pv_tile(f32x16* o, int vb0, bf16x8 pa0, bf16x8 pa1, bf16x8 pa2, bf16x8 pa3) {
#define TRRD(dst, off) asm volatile("ds_read_b64_tr_b16 %0, %1 offset:%2" : "=&v"(dst) : "v"(vb0), "i"(off) : "memory")
#define PV_D0(d0) do { s16x4 l0, l1, l2, l3, h0, h1, h2, h3; constexpr int b_ = VB * SHM_V + v_rd_off(d0, 0, 0);     \
        TRRD(l0, b_); TRRD(h0, b_ + 2048); TRRD(l1, b_ + 4096); TRRD(h1, b_ + 6144); TRRD(l2, b_ + 8192); TRRD(h2, b_ + 10240); TRRD(l3, b_ + 12288); TRRD(h3, b_ + 14336); \
        asm volatile("s_waitcnt lgkmcnt(0)" ::: "memory"); SBAR();                                                                                   \
        o[d0] = __builtin_amdgcn_mfma_f32_32x32x16_bf16(pa0, (bf16x8){l0[0], l0[1], l0[2], l0[3], h0[0], h0[1], h0[2], h0[3]}, o[d0], 0, 0, 0);   \
        o[d0] = __builtin_amdgcn_mfma_f32_32x32x16_bf16(pa1, (bf16x8){l1[0], l1[1], l1[2], l1[3], h1[0], h1[1], h1[2], h1[3]}, o[d0], 0, 0, 0);   \
        o[d0] = __builtin_amdgcn_mfma_f32_32x32x16_bf16(pa2, (bf16x8){l2[0], l2[1], l2[2], l2[3], h2[0], h2[1], h2[2], h2[3]}, o[d0], 0, 0, 0);   \
        o[d0] = __builtin_amdgcn_mfma_f32_32x32x16_bf16(pa3, (bf16x8){l3[0], l3[1], l3[2], l3[3], h3[0], h3[1], h3[2], h3[3]}, o[d0], 0, 0, 0); } while (0)
    PV_D0(0); PV_D0(1); PV_D0(2); PV_D0(3);
#undef PV_D0
#undef TRRD
}

template <int MODE>
__device__ __forceinline__ void attn_unit(AT_LAS char* lds, const bf16_t* Qp, int qpitch, const bf16_t* Kp, const bf16_t* Vp, int kvpitch, const float* cb, int q0, int NT,
                                          bf16_t* Op, int opitch, float lam, const float* subg, float outscale, unsigned* qhead, unsigned& qpre) {
    constexpr int NK = (MODE == 1) ? 4 : 8, SCI = (MODE == 1) ? 64 : 128;
    const int tid = opaque_tid(), wid = __builtin_amdgcn_readfirstlane(tid >> 6), lane = tid & 63, r32 = lane & 31, hi = lane >> 5;
    const int comp = (MODE == 1) ? (wid >> 2) : 0;
    const int wrow = (MODE == 1) ? (wid & 3) * 32 : wid * 32;
    bf16x8 qr[NK];
    { const bf16_t* qrow = Qp + (size_t)(wrow + r32) * qpitch + comp * 64 + hi * 8;
#pragma unroll
      for (int d0 = 0; d0 < NK; ++d0) qr[d0] = *reinterpret_cast<const bf16x8*>(qrow + d0 * 16); }
    AT_LAS char* V_lds = lds + OFF_V; AT_LAS char* K_lds = lds + OFF_K; AT_LAS float* bias_l = (AT_LAS float*)(lds + OFF_BIAS);
    AT_LAS float* ws = (AT_LAS float*)(lds + OFF_WS) + wid * 64; AT_LAS float* li_l = ws; AT_LAS float* al_l = ws + 32;
    const int sr = tid >> 4, sc = (tid & 15) * 8;
    const int vst0 = v_st(sr, sc), vst1 = v_st(32 + sr, sc), kws = KSWZ(sr, sc * 2);
    const int vb0 = (int)(unsigned)(uintptr_t)V_lds + v_rd_base(lane);
    const AT_LAS char* Kq = K_lds + comp * 128;
    const int qlo = q0 + wrow, qm = qlo + r32 - 4 * hi;
    float m_reg = -1e30f, l_reg = 0.f; f32x16 o[4];
#pragma unroll
    for (int d = 0; d < 4; ++d) o[d] = f32x16{};
    bf16x8 st_k0, st_k1, st_v0, st_v1; float st_b = 0.f, carry = 0.f;
    constexpr float BSC = -11.313708498984761f;
#define AT_SLOAD(i) do { if ((i) + 2 < NT) { const size_t r0_ = (size_t)(((i) + 2) * KVBLK + sr) * kvpitch + sc, r1_ = r0_ + (size_t)32 * kvpitch;              \
            st_k0 = *reinterpret_cast<const bf16x8*>(Kp + r0_); st_k1 = *reinterpret_cast<const bf16x8*>(Kp + r1_);                                     \
            if (MODE == 0) { if (tid < 64) st_b = cb[((i) + 2) * KVBLK + tid]; } }                                                                      \
        if ((i) + 1 < NT) { const size_t r0_ = (size_t)(((i) + 1) * KVBLK + sr) * kvpitch + sc, r1_ = r0_ + (size_t)32 * kvpitch;                      \
            st_v0 = *reinterpret_cast<const bf16x8*>(Vp + r0_); st_v1 = *reinterpret_cast<const bf16x8*>(Vp + r1_); } } while (0)
#define AT_SWRITE(i, KB  ) do {                                                                                                           \
        if ((i) + 1 < NT) { *reinterpret_cast<AT_LAS bf16x8*>(K_lds + (1 - (KB)) * SHM_K + kws) = st_k0; *reinterpret_cast<AT_LAS bf16x8*>(K_lds + (1 - (KB)) * SHM_K + kws + 32 * 256) = st_k1; \
            if (MODE == 0) { if (tid < 64) { const float c_ = carry + wave_incl_scan(st_b); bias_l[(((i) + 1) & 3) * 64 + tid] = c_ * BSC; carry = __builtin_bit_cast(float, __builtin_amdgcn_readlane(__builtin_bit_cast(int, c_), 63)); } } }   \
        if ((i) < NT) { *reinterpret_cast<AT_LAS bf16x8*>(V_lds + (KB) * SHM_V + vst0) = st_v0; *reinterpret_cast<AT_LAS bf16x8*>(V_lds + (KB) * SHM_V + vst1) = st_v1; } } while (0)
#define AT_RESC(a) do { if (__any((a) < 1.f)) { if (hi == 0) al_l[r32] = (a); asm volatile("s_waitcnt lgkmcnt(0)" ::: "memory");                        \
        _Pragma("unroll") for (int d_ = 0; d_ < 4; ++d_) _Pragma("unroll") for (int r = 0; r < 16; ++r) o[d_][r] *= al_l[crow(r, hi)]; } } while (0)
#define AT_ITER(i, KB) do {                                                                                                                              \
        AT_SWRITE(i, KB); AT_SLOAD(i); SBAR();                                                                                                          \
        if ((i) < NT) { qkt_load4<0, KB>(kf, Kq, r32, hi); SBAR(); }         \
        if ((i) >= 1) pv_tile<1 - (KB)>(o, vb0, pa0, pa1, pa2, pa3);                                                                                    \
        if ((i) < NT) { SBAR(); p0 = f32x16{}; p1 = f32x16{}; qkt_mfma4<0>(p0, p1, kf, qr);                                                             \
            if (NK == 8) { qkt_load4<4, KB>(kf, Kq, r32, hi); qkt_mfma4<(NK == 8 ? 4 : 0)>(p0, p1, kf, qr); } }                                         \
        if (AT_PROBE_MFMA2) { if ((i) < NT) { asm volatile("" : "+v"(p0), "+v"(p1));     \
            qkt_load4<0, KB>(kf, Kq, r32, hi); p0 = f32x16{}; p1 = f32x16{}; qkt_mfma4<0>(p0, p1, kf, qr);                                             \
            if (NK == 8) { qkt_load4<4, KB>(kf, Kq, r32, hi); qkt_mfma4<(NK == 8 ? 4 : 0)>(p0, p1, kf, qr); } } }                                       \
        SBAR(); __syncthreads();                                                                                                                        \
        if ((i) < NT) {                                                                                                                                 \
            if (MODE == 0) { const AT_LAS float* bl = bias_l + ((i) & 3) * 64 + 4 * hi;                                                                \
                _Pragma("unroll") for (int g = 0; g < 4; ++g) { const f32x4 b0_ = *reinterpret_cast<const AT_LAS f32x4*>(bl + 8 * g), b1_ = *reinterpret_cast<const AT_LAS f32x4*>(bl + 32 + 8 * g); \
                    _Pragma("unroll") for (int e = 0; e < 4; ++e) { p0[4 * g + e] += b0_[e]; p1[4 * g + e] += b1_[e]; } } }                          \
            if (MODE != 2) { const int kb_ = (i) * KVBLK; if (kb_ + KVBLK - 1 > qlo) mask_tile(p0, p1, qm - kb_, 0x7fffffffu); }                       \
            if (AT_PROBE_VALU) { float dm_ = 0.f; _Pragma("unroll") for (int q_ = 0; q_ < 128; ++q_) asm volatile("v_add_f32 %0, %0, %0" : "+v"(dm_)); }     \
            float mn_, al_; partialSM<SCI>(p0, p1, m_reg, mn_, al_);                                                                                   \
            finishSM(p0, p1, al_, l_reg, pa0, pa1, pa2, pa3);                                                                                           \
            AT_RESC(al_); }                                                                                                                             \
        SBAR(); __syncthreads(); if (AT_PROBE_BAR) { __syncthreads(); __syncthreads(); } } while (0)
#ifndef AT_GRP_BY_PARITY
#define AT_GRP_BY_PARITY 0
#endif
    const bool grpA = AT_GRP_BY_PARITY ? (wid & 1) == 0 : wid < 4;
    f32x16 p0, p1; bf16x8 pa0, pa1, pa2, pa3; bf16x8 kf[8];
    { const size_t r0_ = (size_t)sr * kvpitch + sc, r1_ = r0_ + (size_t)32 * kvpitch;
      st_k0 = *reinterpret_cast<const bf16x8*>(Kp + r0_); st_k1 = *reinterpret_cast<const bf16x8*>(Kp + r1_);
      if (MODE == 0) { if (tid < 64) st_b = cb[tid]; }
      asm volatile("s_waitcnt vmcnt(0)" ::: "memory");
      *reinterpret_cast<AT_LAS bf16x8*>(K_lds + kws) = st_k0; *reinterpret_cast<AT_LAS bf16x8*>(K_lds + kws + 32 * 256) = st_k1;
      if (MODE == 0) { if (tid < 64) { const float c_ = wave_incl_scan(st_b); bias_l[tid] = c_ * BSC; carry = __builtin_bit_cast(float, __builtin_amdgcn_readlane(__builtin_bit_cast(int, c_), 63)); } } }
    AT_SLOAD(-1);
    __syncthreads();
    if (!grpA) __syncthreads();
    for (int i = 0; i < NT; i += 2) { AT_ITER(i, 0); AT_ITER(i + 1, 1); }
    if (qhead != nullptr) { if (tid == 0) qpre = __hip_atomic_fetch_add(qhead, 1u, __ATOMIC_RELAXED, __HIP_MEMORY_SCOPE_AGENT); }
    AT_ITER(NT, 0);
    if (grpA) __syncthreads();
#undef AT_ITER
#undef AT_RESC
#undef AT_SWRITE
#undef AT_SLOAD
    if (hi == 0) li_l[r32] = l_reg;
    asm volatile("s_waitcnt lgkmcnt(0)" ::: "memory");
    float rli[16];
#pragma unroll
    for (int r = 0; r < 16; ++r) rli[r] = __builtin_amdgcn_rcpf(li_l[crow(r, hi)]);
    bf16_t* Ow = Op + (size_t)wrow * opitch;
    if (MODE != 1) {
#pragma unroll
        for (int r = 0; r < 16; ++r) { const int orow = crow(r, hi);
#pragma unroll
            for (int d0 = 0; d0 < 4; ++d0) { const float v = o[d0][r] * rli[r]; const float vn = lane_xor1(v);
                if ((r32 & 1) == 0) *(unsigned*)(Ow + (size_t)orow * opitch + d0 * 32 + r32) = cvtpk(v, vn); } }
        __syncthreads();
    } else {
        AT_LAS float* X = (AT_LAS float*)(lds + OFF_X) + (wid & 3) * 4096;
        if (comp == 1) {
#pragma unroll
            for (int r = 0; r < 16; ++r)
#pragma unroll
                for (int d0 = 0; d0 < 4; ++d0) X[crow(r, hi) * 128 + d0 * 32 + r32] = o[d0][r] * rli[r];
        }
        __syncthreads();
        if (comp == 0) {
            float g[4];
#pragma unroll
            for (int d0 = 0; d0 < 4; ++d0) g[d0] = subg[d0 * 32 + r32] * outscale;
#pragma unroll
            for (int r = 0; r < 16; ++r) { const int orow = crow(r, hi); float dv[4]; float s = 0.f;
#pragma unroll
                for (int d0 = 0; d0 < 4; ++d0) { dv[d0] = o[d0][r] * rli[r] - lam * X[orow * 128 + d0 * 32 + r32]; s += dv[d0] * dv[d0]; }
                s = sum32(s);
                const float rms = 1.0f / sqrtf(s * (1.0f / 128.0f) + 1e-6f);
#pragma unroll
                for (int d0 = 0; d0 < 4; ++d0) { const float v = dv[d0] * rms * g[d0]; const float vn = lane_xor1(v);
                    if ((r32 & 1) == 0) *(unsigned*)(Ow + (size_t)orow * opitch + d0 * 32 + r32) = cvtpk(v, vn); } }
        }
        __syncthreads();
    }
}
#undef SBAR
}

constexpr int D = 2048, BATCH = 4, SEQ = 4096, M = BATCH * SEQ, DEPTH = 4, MEMLEN = 256, MMEM = BATCH * MEMLEN;
constexpr int FF = 5632, NGU = 2 * FF, INW = 6150, INP = 6144, CRW = 512, NFH = 6;
constexpr int C_FQ = 0, C_FK = 768, C_FV = 1536, C_DQ = 2304, C_DK = 3072, C_DV = 3840, C_GB = 4608, C_GC = 5120, C_HC = 5632;
constexpr float EPS = 1e-6f;
constexpr int NWAVES = 8, NTHR = 512;
constexpr size_t MiB = 1u << 20;
constexpr size_t WS_CTL = 0, CTL_ZERO_BYTES = 4 * MiB;
constexpr size_t LW_GU1 = 0, LW_D1 = 44 * MiB, LW_GU2 = 66 * MiB, LW_D2 = 110 * MiB, LW_IN = 132 * MiB, LW_OUT = 156 * MiB, LW_Q = 164 * MiB, LW_KV = 166 * MiB, LW_O = 170 * MiB, LW_SIZE = 172 * MiB;
constexpr size_t WS_SSQ = 1 * MiB;
constexpr size_t WS_W = 4 * MiB;
constexpr size_t WS_NB = WS_W + DEPTH * LW_SIZE;
constexpr size_t WS_ACT = WS_NB + 64 * MiB;
constexpr size_t WS_PROJ = WS_ACT + 176 * MiB;
constexpr size_t WS_MIX = WS_PROJ + 192 * MiB;
constexpr size_t WS_QC = WS_MIX + 64 * MiB;
constexpr size_t WS_OC = WS_QC + 16 * MiB;
constexpr size_t WS_KV = WS_OC + 16 * MiB;
constexpr size_t WS_MEMN = WS_KV + 8 * MiB;
constexpr size_t WS_LOGF = WS_MEMN + 16 * MiB;
constexpr size_t WS_CUM = WS_LOGF + 1 * MiB;
constexpr size_t WS_ROPE = WS_CUM + 1 * MiB;
constexpr size_t WS_WFF = WS_ROPE + 1 * MiB;
constexpr size_t WS_END = WS_WFF + 1 * MiB;
static_assert(WS_SSQ + 18 * (size_t)M * 8 <= CTL_ZERO_BYTES, "ssq accumulators inside the memset region");
static_assert((size_t)NGU * D * 2 == 44 * MiB && (size_t)D * FF * 2 == 22 * MiB && (size_t)INP * D * 2 == 24 * MiB && (size_t)M * FF * 2 == 176 * MiB && (size_t)M * INP * 2 == 192 * MiB, "ws map");
constexpr int CW_BAR = 4096;
constexpr int CW_BIN = 8192;
constexpr int CW_GRP = 9216, CW_GXCC = 14336;
constexpr int CW_QUEUE = 16384;
constexpr int RING_OFF = 0, RING_BYTES = 131072;
constexpr int LDSCTL_OFF = RING_BYTES, MISC_OFF = LDSCTL_OFF + 320, RED_OFF = LDSCTL_OFF + 1024, RSC_OFF = LDSCTL_OFF + 5120;
constexpr int LDS_BYTES = 147456;
static_assert(at::ATT_LDS <= RING_BYTES, "attention scratch fits the ring region");

#define GAS __attribute__((address_space(1)))
#define LAS __attribute__((address_space(3)))
typedef unsigned short bf16;
typedef unsigned v4u __attribute__((ext_vector_type(4)));
typedef unsigned v2u __attribute__((ext_vector_type(2)));
typedef float f32x4 __attribute__((ext_vector_type(4)));
typedef float f32x2 __attribute__((ext_vector_type(2)));
typedef short bf16x8 __attribute__((ext_vector_type(8)));
typedef GAS unsigned gu32;
#define RLX_AGENT __ATOMIC_RELAXED, __HIP_MEMORY_SCOPE_AGENT
#define LDS_WAIT() asm volatile("s_waitcnt lgkmcnt(0)" ::: "memory")
#define VM_WAIT() asm volatile("s_waitcnt vmcnt(0)" ::: "memory")
__device__ __forceinline__ unsigned f2bf(float f) { unsigned u = __builtin_bit_cast(unsigned, f); return (u + 0x7fffu + ((u >> 16) & 1u)) >> 16; }
__device__ __forceinline__ unsigned pk2(float lo, float hi) { return f2bf(lo) | (f2bf(hi) << 16); }
__device__ __forceinline__ float bf_lo(unsigned w) { return __builtin_bit_cast(float, w << 16); }
__device__ __forceinline__ float bf_hi(unsigned w) { return __builtin_bit_cast(float, w & 0xffff0000u); }
template <int CTRL> __device__ __forceinline__ float dpp_f(float v) { return __builtin_bit_cast(float, __builtin_amdgcn_update_dpp(0, __builtin_bit_cast(int, v), CTRL, 0xF, 0xF, true)); }
__device__ __forceinline__ float wave_sum(float v) {
    v += dpp_f<0xB1>(v); v += dpp_f<0x4E>(v);
    v += dpp_f<0x141>(v); v += dpp_f<0x140>(v);
    v += __shfl_xor(v, 16);
    { auto rr = __builtin_amdgcn_permlane32_swap(__float_as_uint(v), __float_as_uint(v), false, false);
      v = __uint_as_float(rr[0]) + __uint_as_float(rr[1]); }
    return v;
}
#define XB_TMO      128
#define XB_XCNT(j)  (256  + 64 * (j))
#define XB_XSUB(j)  (1280 + 64 * (j))
#define XB_XGEN(j)  (2304 + 64 * (j))
#define XB_TOP      3328
#define XB_TOPGEN   3392
#define XCD_BAR_WORDS 3456
#define XB_SPIN_CAP (1u << 18)

__device__ __forceinline__ unsigned xb_ld(unsigned* p)              { return __hip_atomic_load(p, __ATOMIC_RELAXED, __HIP_MEMORY_SCOPE_AGENT); }
__device__ __forceinline__ unsigned xb_add(unsigned* p, unsigned v) { return __hip_atomic_fetch_add(p, v, __ATOMIC_RELAXED, __HIP_MEMORY_SCOPE_AGENT); }
__device__ __forceinline__ unsigned xb_xcc_id() { return (unsigned)__builtin_amdgcn_s_getreg((3 << 11) | 20) & 0xFu; }
#define XB_SPIN(cond, bar) do { unsigned _sp = 0; while (cond) { __builtin_amdgcn_s_sleep(1); \
    if ((++_sp & 255u) == 0u) { if (xb_ld(&(bar)[XB_TMO])) break; if (_sp > XB_SPIN_CAP) { atomicAdd(&(bar)[XB_TMO], 1u); break; } } } } while (0)

struct XcdBarrier {
    unsigned* bar; unsigned x;
    volatile LAS unsigned* st;
};

__device__ __forceinline__ XcdBarrier xcd_barrier_post(unsigned* bar, volatile LAS unsigned* st) {
    XcdBarrier b; b.bar = bar; b.x = xb_xcc_id(); b.st = st;
    if (threadIdx.x == 0) (void)xb_add(&bar[XB_XCNT(b.x)], 1u);
    return b;
}
__device__ __forceinline__ void xcd_barrier_complete(unsigned* bar, unsigned x, unsigned& nloc, unsigned& nx) {
    const unsigned G = gridDim.x * gridDim.y * gridDim.z;
    unsigned sum, cnt, mine, sp = 0u;
    for (;;) {
        sum = 0u; cnt = 0u; mine = 0u;
#pragma unroll
        for (unsigned j = 0; j < 16; ++j) { const unsigned c = xb_ld(&bar[XB_XCNT(j)]); sum += c; cnt += (c > 0u) ? 1u : 0u; mine = (j == x) ? c : mine; }
        if (sum == G) break;
        __builtin_amdgcn_s_sleep(1);
        if ((++sp & 255u) == 0u) { if (xb_ld(&bar[XB_TMO])) break; if (sp > XB_SPIN_CAP) { atomicAdd(&bar[XB_TMO], 1u); break; } }
    }
    nloc = mine > 0u ? mine : 1u; nx = cnt > 0u ? cnt : 1u;
}

__device__ __forceinline__ void xcd_barrier(const XcdBarrier& b) {
    asm volatile("s_waitcnt vmcnt(0)" ::: "memory");
    __syncthreads();
    if (threadIdx.x == 0) {
        unsigned* bar = b.bar;
        __builtin_amdgcn_s_waitcnt(0);
        unsigned nloc = b.st[0], nx = b.st[1];
        if (nloc == 0u) { xcd_barrier_complete(bar, b.x, nloc, nx); b.st[0] = nloc; b.st[1] = nx; }
        const unsigned old = xb_add(&bar[XB_XSUB(b.x)], 1u);
        const unsigned gen = old / nloc;
        if (old + 1u == (gen + 1u) * nloc) {
            __builtin_amdgcn_fence(__ATOMIC_RELEASE, "agent");
            asm volatile("s_waitcnt vmcnt(0)" ::: "memory");
            const unsigned og = xb_add(&bar[XB_TOP], 1u);
            const unsigned tg = og / nx;
            if (og + 1u == (tg + 1u) * nx) xb_add(&bar[XB_TOPGEN], 1u);
            else XB_SPIN(xb_ld(&bar[XB_TOPGEN]) == tg, bar);
            __builtin_amdgcn_fence(__ATOMIC_ACQUIRE, "agent");
            xb_add(&bar[XB_XGEN(b.x)], 1u);
            asm volatile("s_waitcnt vmcnt(0)" ::: "memory");
        } else {
            XB_SPIN(xb_ld(&bar[XB_XGEN(b.x)]) == gen, bar);
            __builtin_amdgcn_fence(__ATOMIC_ACQUIRE, "agent");
            asm volatile("s_waitcnt vmcnt(0)" ::: "memory");
        }
    }
    __syncthreads();
}

__device__ __forceinline__ void group_barrier(unsigned* ctlw, volatile LAS unsigned* gst) {
    asm volatile("s_waitcnt vmcnt(0)" ::: "memory");
    __syncthreads();
    if (threadIdx.x == 0) {
        __builtin_amdgcn_s_waitcnt(0);
        const unsigned c = blockIdx.x, ep = gst[0] + 1u; unsigned same = gst[1]; gst[0] = ep;
        unsigned* bar = ctlw + CW_BAR; unsigned* cnt = ctlw + CW_GRP + 64 * (c & 63u);
        if (same == 0u) { const unsigned* gx = ctlw + CW_GXCC + (c & 63u); const unsigned x0 = xb_ld((unsigned*)gx), x1 = xb_ld((unsigned*)gx + 64), x2 = xb_ld((unsigned*)gx + 128), x3 = xb_ld((unsigned*)gx + 192);
            same = (x0 != 0u && x0 == x1 && x0 == x2 && x0 == x3) ? 2u : 1u; gst[1] = same; }
        if (same != 2u) { __builtin_amdgcn_fence(__ATOMIC_RELEASE, "agent"); asm volatile("s_waitcnt vmcnt(0)" ::: "memory"); }
        (void)xb_add(cnt, 1u);
        XB_SPIN(xb_ld(cnt) < 4u * ep, bar);
        __builtin_amdgcn_fence(__ATOMIC_ACQUIRE, "agent");
        asm volatile("s_waitcnt vmcnt(0)" ::: "memory");
    }
    __syncthreads();
}

struct Ready { unsigned* ctlw; unsigned target; volatile LAS unsigned* known; bool on; };
__device__ __forceinline__ void batch_post(unsigned* ctlw, unsigned b) {
    asm volatile("s_waitcnt vmcnt(0)" ::: "memory");
    __syncthreads();
    if (threadIdx.x == 0) { __builtin_amdgcn_s_waitcnt(0); __builtin_amdgcn_fence(__ATOMIC_RELEASE, "agent"); asm volatile("s_waitcnt vmcnt(0)" ::: "memory"); (void)xb_add(ctlw + CW_BIN + 64 * b, 1u); }
}
__device__ __forceinline__ void ready_wait(const Ready& r, int b) {
    if (!r.on || r.known[b] >= r.target) return;
    unsigned* bar = r.ctlw + CW_BAR;
    XB_SPIN(xb_ld(r.ctlw + CW_BIN + 64 * b) < r.target, bar);
    __builtin_amdgcn_fence(__ATOMIC_ACQUIRE, "agent");
    asm volatile("s_waitcnt vmcnt(0)" ::: "memory");
    r.known[b] = r.target;
}

struct Params { const float* in[28]; float* out; unsigned char* ws; int s_lo, s_hi; };
enum { I_X = 0, I_MEM, I_POS, I_F1N, I_F1G, I_F1U, I_F1D, I_MIXN, I_WIN, I_FBIAS, I_CONVW, I_CONVB, I_LQ1, I_LK1, I_LQ2, I_LK2, I_SUBLN, I_WOUT, I_CRN, I_MEMN, I_CWQ, I_CWKV, I_CWO, I_F2N, I_F2G, I_F2U, I_F2D, I_FINN };

__device__ __forceinline__ void tr_item(const float* W, int pitch, int k0, int ncol0, bf16* WT, int K, int drow0, LAS float* scr, int lane, const float* gain) {
#pragma unroll 8
    for (int i = 0; i < 32; ++i) { const int kk = 2 * i + (lane >> 5); scr[kk * 33 + (lane & 31)] = W[(size_t)(k0 + kk) * pitch + ncol0 + (lane & 31)]; }
    LDS_WAIT(); asm volatile("" ::: "memory");
    const int c = lane & 7;
    f32x4 g0 = {1.f, 1.f, 1.f, 1.f}, g1 = g0;
    if (gain) { g0 = *(const GAS f32x4*)(gain + k0 + 8 * c); g1 = *(const GAS f32x4*)(gain + k0 + 8 * c + 4); }
#pragma unroll
    for (int j = 0; j < 4; ++j) { const int n = (lane >> 3) + 8 * j; const LAS float* s = scr + (8 * c) * 33 + n;
        v4u o; o.x = pk2(s[0 * 33] * g0.x, s[1 * 33] * g0.y); o.y = pk2(s[2 * 33] * g0.z, s[3 * 33] * g0.w); o.z = pk2(s[4 * 33] * g1.x, s[5 * 33] * g1.y); o.w = pk2(s[6 * 33] * g1.z, s[7 * 33] * g1.w);
        *(GAS v4u*)(WT + (size_t)(drow0 + n) * K + k0 + 8 * c) = o; }
    LDS_WAIT(); asm volatile("" ::: "memory");
}
constexpr int IT_GU = (D / 64) * (FF / 32), IT_DN = (FF / 64) * (D / 32), IT_INA = (D / 64) * (2304 / 32), IT_INB = (D / 64) * (3840 / 32), IT_OUT = (D / 64) * (D / 32),
              IT_Q = (D / 64) * (CRW / 32), IT_KV = (D / 64) * (2 * CRW / 32), IT_O = (CRW / 64) * (D / 32);
constexpr int IT_LAYER = 4 * IT_GU + 2 * IT_DN + IT_INA + IT_INB + IT_OUT + IT_Q + IT_KV + IT_O;

__device__ __forceinline__ void prologue_weights(const Params& p, LAS unsigned char* lds, int gw, int NGW, int wave, int lane) {
    LAS float* scr = (LAS float*)(lds + RING_OFF + wave * 16384);
    for (int it = gw; it < DEPTH * IT_LAYER; it += NGW) {
        const int l = it / IT_LAYER; int r = it % IT_LAYER;
        bf16* wl = (bf16*)(p.ws + WS_W + (size_t)l * LW_SIZE);
#define GUJOB(IDX, DSTOFF, UP, GIDX) if (r < IT_GU) { const int kb = r / (FF / 32), nb = r % (FF / 32), n0 = 32 * nb;                                                   \
            tr_item(p.in[IDX] + (size_t)l * D * FF, FF, 64 * kb, n0, (bf16*)((unsigned char*)wl + (DSTOFF)), D, (n0 >> 7) * 256 + (n0 & 127) + (UP) * 128, scr, lane, p.in[GIDX] + (size_t)l * D); continue; } r -= IT_GU;
#define PLJOB(CNT, IDX, LSTRIDE, PITCH, KDIM, NBLK, COL0, DSTOFF, DROW0, GAINP) if (r < (CNT)) { const int kb = r / (NBLK), nb = r % (NBLK);                              \
            tr_item(p.in[IDX] + (size_t)l * (LSTRIDE), PITCH, 64 * kb, (COL0) + 32 * nb, (bf16*)((unsigned char*)wl + (DSTOFF)), KDIM, (DROW0) + 32 * nb, scr, lane, GAINP); continue; } r -= (CNT);
        GUJOB(I_F1G, LW_GU1, 0, I_F1N)
        GUJOB(I_F1U, LW_GU1, 1, I_F1N)
        PLJOB(IT_DN, I_F1D, (size_t)FF * D, D, FF, D / 32, 0, LW_D1, 0, nullptr)
        GUJOB(I_F2G, LW_GU2, 0, I_F2N)
        GUJOB(I_F2U, LW_GU2, 1, I_F2N)
        PLJOB(IT_DN, I_F2D, (size_t)FF * D, D, FF, D / 32, 0, LW_D2, 0, nullptr)
        PLJOB(IT_INA, I_WIN, (size_t)D * INW, INW, D, 2304 / 32, 0, LW_IN, 0, p.in[I_MIXN] + (size_t)l * D)
        PLJOB(IT_INB, I_WIN, (size_t)D * INW, INW, D, 3840 / 32, 2310, LW_IN, 2304, p.in[I_MIXN] + (size_t)l * D)
        PLJOB(IT_OUT, I_WOUT, (size_t)D * D, D, D, D / 32, 0, LW_OUT, 0, nullptr)
        PLJOB(IT_Q, I_CWQ, (size_t)D * CRW, CRW, D, CRW / 32, 0, LW_Q, 0, p.in[I_CRN] + (size_t)l * D)
        PLJOB(IT_KV, I_CWKV, (size_t)D * 2 * CRW, 2 * CRW, D, 2 * CRW / 32, 0, LW_KV, 0, nullptr)
        PLJOB(IT_O, I_CWO, (size_t)CRW * D, D, CRW, D / 32, 0, LW_O, 0, nullptr)
#undef GUJOB
#undef PLJOB
    }
}

__device__ __forceinline__ void x_rows(const float* x, bf16* hb, unsigned long long* ssq, int gw, int NGW, int lane) {
    for (int m = gw; m < M; m += NGW) {
        const GAS f32x4* xr = (const GAS f32x4*)(x + (size_t)m * D) + lane;
        f32x4 v[8]; float s = 0.f;
#pragma unroll
        for (int j = 0; j < 8; ++j) { v[j] = xr[64 * j]; s += (v[j].x * v[j].x + v[j].y * v[j].y) + (v[j].z * v[j].z + v[j].w * v[j].w); }
        s = wave_sum(s);
        GAS v2u* o = (GAS v2u*)(hb + (size_t)m * D) + lane;
#pragma unroll
        for (int j = 0; j < 8; ++j) { v2u w; w.x = pk2(v[j].x, v[j].y); w.y = pk2(v[j].z, v[j].w); o[64 * j] = w; }
        if (lane == 0) ssq[m] = (unsigned long long)(s * pg8::SSQ_FIX);
    }
}
__device__ __forceinline__ void ff_tile(const bf16* hb, const unsigned long long* ssq, const bf16* wff  , const float* fbias, float* logfT, int m0, int wave, int lane, LAS float* xch) {
    const int fr = lane & 15, fq = lane >> 4, tile = wave & 3, kh = wave >> 2, row = m0 + tile * 16 + fr;
    const bf16* hp = hb + (size_t)row * D + kh * (D / 2) + 8 * fq; const bf16* wp = wff + (size_t)(fr < NFH ? fr : 0) * D + kh * (D / 2) + 8 * fq;
    pg8::f32x4 acc = {0.f, 0.f, 0.f, 0.f};
#pragma unroll 1
    for (int s0 = 0; s0 < D / 2 / 32; s0 += 16) {
        pg8::bf16x8 hf[16], wf[16];
#pragma unroll
        for (int s = 0; s < 16; ++s) { hf[s] = *(const GAS pg8::bf16x8*)(hp + (s0 + s) * 32); wf[s] = *(const GAS pg8::bf16x8*)(wp + (s0 + s) * 32); }
#pragma unroll
        for (int s = 0; s < 16; ++s) { const pg8::bf16x8 w = fr < NFH ? wf[s] : (pg8::bf16x8){0, 0, 0, 0, 0, 0, 0, 0}; acc = __builtin_amdgcn_mfma_f32_16x16x32_bf16(w, hf[s], acc, 0, 0, 0); }
    }
    if (kh == 1) *(LAS pg8::f32x4*)(xch + (tile * 64 + lane) * 4) = acc;
    __syncthreads();
    if (kh == 0 && fq < 2) {
        const pg8::f32x4 o = *(const LAS pg8::f32x4*)(xch + (tile * 64 + lane) * 4);
        const float rstd = 1.0f / sqrtf((float)ssq[row] * (pg8::SSQ_UNFIX / D) + EPS);
        const int b = row / SEQ, t = row % SEQ;
#pragma unroll
        for (int i = 0; i < 4; ++i) { const int j = 4 * fq + i;
            if (j < NFH) { const float z = (acc[i] + o[i]) * rstd + fbias[j]; logfT[(size_t)(b * NFH + j) * SEQ + t] = fminf(z, 0.f) - log1pf(expf(-fabsf(z))); } }
    }
}
__device__ __forceinline__ void out_norm_rows(const bf16* hb, float* out, const float* gain, int m0, int mstep, int cnt, int lane) {
    f32x4 g[8];
#pragma unroll
    for (int j = 0; j < 8; ++j) g[j] = ((const GAS f32x4*)gain)[lane + 64 * j];
    for (int k = 0; k < cnt; ++k) { const int m = m0 + k * mstep;
        const GAS v2u* xr = (const GAS v2u*)(hb + (size_t)m * D) + lane;
        f32x4 v[8]; float s = 0.f;
#pragma unroll
        for (int j = 0; j < 8; ++j) { const v2u w = xr[64 * j]; v[j] = (f32x4){bf_lo(w.x), bf_hi(w.x), bf_lo(w.y), bf_hi(w.y)}; s += (v[j].x * v[j].x + v[j].y * v[j].y) + (v[j].z * v[j].z + v[j].w * v[j].w); }
        const float rstd = 1.0f / sqrtf(wave_sum(s) * (1.0f / D) + EPS);
        GAS f32x4* o = (GAS f32x4*)(out + (size_t)m * D) + lane;
#pragma unroll
        for (int j = 0; j < 8; ++j) o[64 * j] = (v[j] * rstd) * g[j];
    }
}

__device__ __forceinline__ void memn_rows(const Params& p, int gw, int NGW, int lane) {
    bf16* dst = (bf16*)(p.ws + WS_MEMN);
    for (int m = gw; m < DEPTH * MMEM; m += NGW) {
        const int l = m / MMEM, r = m % MMEM;
        const GAS f32x4* xr = (const GAS f32x4*)(p.in[I_MEM] + (size_t)r * D) + lane; const GAS f32x4* gr = (const GAS f32x4*)(p.in[I_MEMN] + (size_t)l * D) + lane;
        f32x4 v[8]; float s = 0.f;
#pragma unroll
        for (int j = 0; j < 8; ++j) { v[j] = xr[64 * j]; s += (v[j].x * v[j].x + v[j].y * v[j].y) + (v[j].z * v[j].z + v[j].w * v[j].w); }
        const float rstd = 1.0f / sqrtf(wave_sum(s) * (1.0f / D) + EPS);
        GAS v2u* o = (GAS v2u*)(dst + (size_t)m * D) + lane;
#pragma unroll
        for (int j = 0; j < 8; ++j) { const f32x4 y = (v[j] * rstd) * gr[64 * j]; v2u w; w.x = pk2(y.x, y.y); w.y = pk2(y.z, y.w); o[64 * j] = w; }
    }
}

__device__ __forceinline__ void wff_table(const Params& p, int gtid, int GT) {
    bf16* tab = (bf16*)(p.ws + WS_WFF);
    for (int i = gtid; i < DEPTH * D; i += GT) { const int l = i / D, k = i % D; const float g = p.in[I_MIXN][i]; const float* w = p.in[I_WIN] + ((size_t)l * D + k) * INW + 2304;
#pragma unroll
        for (int j = 0; j < NFH; ++j) tab[(l * NFH + j) * D + k] = (bf16)(pk2(g * w[j], 0.f) & 0xffffu); }
}
__device__ __forceinline__ float rope_invf(int f) {
    return f == 0 ? 1.0f : f == 1 ? 0.1939227432012558f : f == 2 ? 0.03760603070259094f : f == 3 ? 0.007292664609849453f : f == 4 ? 0.0014142135623842478f : f == 5 ? 0.00027424818836152554f : f == 6 ? 5.318296098266728e-05f : 1.0313386155758053e-05f;
}
__device__ __forceinline__ void rope_table(const Params& p, int gtid, int GT) {
    float* tab = (float*)(p.ws + WS_ROPE); const int* pos = (const int*)p.in[I_POS];
    for (int i = gtid; i < M * 8; i += GT) { const int tok = i >> 3, f = i & 7;
        const float ang = (float)pos[tok] * rope_invf(f);
        double rev = (double)ang * 0.15915494309189535; rev -= __builtin_rint(rev);
        const float fr = (float)rev;
        tab[tok * 16 + f] = __builtin_amdgcn_cosf(fr); tab[tok * 16 + 8 + f] = __builtin_amdgcn_sinf(fr); }
}

__device__ __forceinline__ void conv_rows(const Params& p, int l, int i0, int i1, int GT) {
    const bf16* proj = (const bf16*)(p.ws + WS_PROJ); bf16* mix = (bf16*)(p.ws + WS_MIX);
    const float* cw = p.in[I_CONVW] + (size_t)l * 3 * CRW; const float* cbias = p.in[I_CONVB] + (size_t)l * CRW;
    for (int i = i0; i < i1; i += GT) { const int tok = i >> 6, ch0 = (i & 63) * 8, t = tok % SEQ;
        const bf16* row = proj + (size_t)tok * INP;
        float z[3][8];
#pragma unroll
        for (int d = 0; d < 3; ++d) {
            if (t >= 2 - d) { const bf16* rr = row - (size_t)(2 - d) * INP; const v4u gc = *(const GAS v4u*)(rr + C_GC + ch0), hc = *(const GAS v4u*)(rr + C_HC + ch0);
                z[d][0] = bf_lo(gc.x) * bf_lo(hc.x); z[d][1] = bf_hi(gc.x) * bf_hi(hc.x); z[d][2] = bf_lo(gc.y) * bf_lo(hc.y); z[d][3] = bf_hi(gc.y) * bf_hi(hc.y);
                z[d][4] = bf_lo(gc.z) * bf_lo(hc.z); z[d][5] = bf_hi(gc.z) * bf_hi(hc.z); z[d][6] = bf_lo(gc.w) * bf_lo(hc.w); z[d][7] = bf_hi(gc.w) * bf_hi(hc.w);
            } else {
#pragma unroll
                for (int e = 0; e < 8; ++e) z[d][e] = 0.f; } }
        const v4u gbv = *(const GAS v4u*)(row + C_GB + ch0);
        const float gb[8] = {bf_lo(gbv.x), bf_hi(gbv.x), bf_lo(gbv.y), bf_hi(gbv.y), bf_lo(gbv.z), bf_hi(gbv.z), bf_lo(gbv.w), bf_hi(gbv.w)};
        float y[8];
#pragma unroll
        for (int e = 0; e < 8; ++e) { const int ch = ch0 + e; y[e] = gb[e] * (z[0][e] * cw[ch] + z[1][e] * cw[CRW + ch] + z[2][e] * cw[2 * CRW + ch] + cbias[ch]); }
        v4u o; o.x = pk2(y[0], y[1]); o.y = pk2(y[2], y[3]); o.z = pk2(y[4], y[5]); o.w = pk2(y[6], y[7]);
        *(GAS v4u*)(mix + (size_t)tok * D + 1536 + ch0) = o; }
}

__device__ __forceinline__ int queue_next(unsigned* head, LAS unsigned char* lds) {
    __syncthreads();
    if (opaque_tid() == 0) *(volatile LAS int*)(lds + RING_OFF + at::OFF_Q) = (int)__hip_atomic_fetch_add(head, 1u, RLX_AGENT);
    __syncthreads();
    return *(volatile LAS int*)(lds + RING_OFF + at::OFF_Q);
}
__device__ __forceinline__ int queue8_search(unsigned* heads, int per_queue, int& cur, LAS unsigned char* lds, bool try_cur, const Ready& rd) {
    __syncthreads();
    const int tid = opaque_tid();
    if (tid < 64) { int c = cur, idx = -1;
        if (try_cur) { idx = __builtin_amdgcn_readfirstlane(tid == 0 ? (int)__hip_atomic_fetch_add(heads + 64 * c, 1u, RLX_AGENT) : 0); if (idx >= per_queue) idx = -1; }
        while (idx < 0) {
            const unsigned hv = tid < 8 ? __hip_atomic_load(heads + 64 * tid, RLX_AGENT) : 0xffffffffu;
            const unsigned open = (unsigned)__ballot(hv < (unsigned)per_queue) & 0xffu;
            if (open == 0u) break;
            const unsigned rot = ((open >> c) | (open << (8 - c))) & 0xffu; c = (c + __builtin_ctz(rot)) & 7;
            idx = __builtin_amdgcn_readfirstlane(tid == 0 ? (int)__hip_atomic_fetch_add(heads + 64 * c, 1u, RLX_AGENT) : 0); if (idx >= per_queue) idx = -1; }
        if (tid == 0) { if (idx >= 0) ready_wait(rd, c >> 1); volatile LAS int* q = (volatile LAS int*)(lds + RING_OFF + at::OFF_Q); q[0] = idx; q[1] = c; } }
    __syncthreads();
    volatile LAS int* q = (volatile LAS int*)(lds + RING_OFF + at::OFF_Q);
    cur = q[1]; return q[0];
}
__device__ __forceinline__ int queue8_next(unsigned* heads, int per_queue, int& cur, LAS unsigned char* lds, const Ready& rd) { return queue8_search(heads, per_queue, cur, lds, true, rd); }
__device__ __forceinline__ int queue8_take(unsigned pre, unsigned* heads, int per_queue, int& cur, LAS unsigned char* lds, const Ready& rd) {
    __syncthreads();
    if (opaque_tid() == 0) { if ((int)pre < per_queue) ready_wait(rd, cur >> 1); *(volatile LAS int*)(lds + RING_OFF + at::OFF_Q) = (int)pre; }
    __syncthreads();
    int idx = *(volatile LAS int*)(lds + RING_OFF + at::OFF_Q);
    if (idx >= per_queue) idx = queue8_search(heads, per_queue, cur, lds, false, rd);
    return idx;
}

struct KvOrder : pg8::StaticOrder {
    size_t lstride;
    __device__ __forceinline__ const char* bptr(const pg8::Gemm& g, const pg8::Unit& u, size_t tstep) const { return (const char*)g.Bt + (size_t)(u.pm >> 2) * lstride + (size_t)u.pn * tstep; }
};

#define PHFN __device__ __forceinline__
PHFN void ph_prologue(const Params& p, LAS unsigned char* lds) {
    const int tid = opaque_tid(), lane = tid & 63, wave = __builtin_amdgcn_readfirstlane(tid >> 6);
    const int G = gridDim.x, gw = blockIdx.x * NWAVES + wave, NGW = G * NWAVES, gtid = blockIdx.x * NTHR + tid, GT = G * NTHR;
    prologue_weights(p, lds, gw, NGW, wave, lane);
    rope_table(p, gtid, GT);
    memn_rows(p, gw, NGW, lane);
    wff_table(p, gtid, GT);
    x_rows(p.in[I_X], (bf16*)(p.ws + WS_NB), (unsigned long long*)(p.ws + WS_SSQ), gw, NGW, lane);
}
PHFN void local_rows(int wave, int& m0, int& mstep, int& cnt) {
    const int c = (int)blockIdx.x;
    if (gridDim.x == 256) { m0 = ((c & 7) * 8 + ((c >> 3) & 7)) * 256 + (c >> 6) * 64 + wave * 8; mstep = 1; cnt = 8; }
    else { m0 = c * NWAVES + wave; mstep = (int)gridDim.x * NWAVES; cnt = (M - m0 + mstep - 1) / mstep; }
}
PHFN void ph_norm_out(const bf16* hb, float* out, const float* gain) {
    const int tid = opaque_tid(), lane = tid & 63, wave = __builtin_amdgcn_readfirstlane(tid >> 6);
    int m0, mstep, cnt; local_rows(wave, m0, mstep, cnt);
    out_norm_rows(hb, out, gain, m0, mstep, cnt, lane);
}
PHFN void ph_ff(const bf16* h, const unsigned long long* ssq, const bf16* wfft  , const float* fbias, float* logfT, LAS unsigned char* lds) {
    const int tid = opaque_tid(), lane = tid & 63, wave = __builtin_amdgcn_readfirstlane(tid >> 6), c = (int)blockIdx.x;
    if (gridDim.x == 256) ff_tile(h, ssq, wfft, fbias, logfT, ((c & 7) * 8 + ((c >> 3) & 7)) * 256 + (c >> 6) * 64, wave, lane, (LAS float*)(lds + RING_OFF));
    else for (int tb = c; tb < M / 64; tb += (int)gridDim.x) { ff_tile(h, ssq, wfft, fbias, logfT, tb * 64, wave, lane, (LAS float*)(lds + RING_OFF)); __syncthreads(); }
    __syncthreads();
}
PHFN void ph_gemm_kv(LAS unsigned char* lds, const bf16* A, const bf16* Bt, bf16* O) {
    pg8::Gemm g{A, Bt, DEPTH * MMEM, 2 * CRW, D};
    KvOrder S; S.init(DEPTH * MMEM, 2 * CRW, gridDim.x, (int)blockIdx.x); S.lstride = LW_SIZE;
    pg8::EpiBf16 E{{nullptr, (LAS float*)(lds + RSC_OFF)}, O, 2 * CRW, nullptr, 0, 0};
    pg8::gemm_phase<pg8::EpiBf16, KvOrder, true, true>(lds + RING_OFF, g, S, E);
}
PHFN void ph_gemm_swiglu(LAS unsigned char* lds, const bf16* A, const bf16* Bt, bf16* O, const unsigned long long* ssq, int fixedp = 0) {
    pg8::Gemm g{A, Bt, M, NGU, D};
    pg8::StaticOrder S; S.init(M, NGU, gridDim.x, (int)blockIdx.x); S.fixedp = fixedp;
    pg8::EpiSwiglu E{{ssq, (LAS float*)(lds + RSC_OFF)}, O, FF};
    pg8::gemm_phase<pg8::EpiSwiglu, pg8::StaticOrder, true, true>(lds + RING_OFF, g, S, E);
}
PHFN void ph_gemm_resid(LAS unsigned char* lds, const bf16* A, const bf16* Bt, int K, bf16* hb, unsigned long long* ssq, float s) {
    pg8::Gemm g{A, Bt, M, D, K};
    pg8::StaticOrder S; S.init(M, D, gridDim.x, (int)blockIdx.x);
    pg8::EpiResid E{hb, ssq, D, s, (LAS float*)(lds + RED_OFF)};
    pg8::gemm_phase<pg8::EpiResid, pg8::StaticOrder, true, true>(lds + RING_OFF, g, S, E);
}
PHFN void ph_gemm_bf16(LAS unsigned char* lds, const bf16* A, const bf16* Bt, int N, bf16* O, const unsigned long long* ssq, const float* rope) {
    pg8::Gemm g{A, Bt, M, N, D};
    pg8::StaticOrder S; S.init(M, N, gridDim.x, (int)blockIdx.x);
    pg8::EpiBf16 E{{ssq, (LAS float*)(lds + RSC_OFF)}, O, N, rope, C_DQ / 256, C_DV / 256};
    pg8::gemm_phase<pg8::EpiBf16, pg8::StaticOrder, true, true>(lds + RING_OFF, g, S, E);
}
PHFN void ph_conv(const Params& p, int l, unsigned* head, LAS unsigned char* lds, const Ready& rd) {
    constexpr int CHUNK = 4 * NTHR, NCHUNK = M * 64 / CHUNK;
    if (opaque_tid() == 0) { for (int b = 0; b < BATCH; ++b) ready_wait(rd, b); }
    int c = queue_next(head, lds);
    while (c < NCHUNK) {
        const int tid = opaque_tid();
        const unsigned pre = tid == 0 ? __hip_atomic_fetch_add(head, 1u, RLX_AGENT) : 0u;
        conv_rows(p, l, c * CHUNK + tid, (c + 1) * CHUNK, NTHR);
        __syncthreads();
        if (tid == 0) *(volatile LAS int*)(lds + RING_OFF + at::OFF_Q) = (int)pre;
        __syncthreads();
        c = *(volatile LAS int*)(lds + RING_OFF + at::OFF_Q);
    }
}
PHFN void ph_attn_fox(LAS unsigned char* lds, const bf16* PROJ, const float* LOGF, bf16* MIX, unsigned* heads, const Ready& rd) {
    int cur = (int)(xb_xcc_id() & 7u);
    for (int idx = queue8_next(heads, 48, cur, lds, rd); idx >= 0; ) {
        unsigned pre = 0u;
        const int qb = 15 - idx / 3, b = cur >> 1, h = (cur & 1) * 3 + idx % 3; const size_t tok0 = (size_t)b * SEQ;
        at::attn_unit<0>((LAS char*)(lds + RING_OFF), PROJ + (tok0 + qb * 256) * INP + C_FQ + h * 128, INP, PROJ + tok0 * INP + C_FK + h * 128, PROJ + tok0 * INP + C_FV + h * 128, INP,
                         LOGF + (size_t)(b * NFH + h) * SEQ, qb * 256, 4 * (qb + 1), MIX + (tok0 + qb * 256) * D + h * 128, D, 0.f, nullptr, 0.f, heads + 64 * cur, pre);
        idx = queue8_take(pre, heads, 48, cur, lds, rd);
    }
}
PHFN void ph_attn_diff(LAS unsigned char* lds, const bf16* PROJ, bf16* MIX, unsigned* heads, const float* lq1, const float* lk1, const float* lq2, const float* lk2, const float* subg, int l, const Ready& rd) {
    const int lane = opaque_tid() & 63;
    const float lam_init = 0.8f - 0.6f * expf(-0.3f * (float)l);
    const float lam = expf(wave_sum(lq1[lane] * lk1[lane])) - expf(wave_sum(lq2[lane] * lk2[lane])) + lam_init;
    int cur = (int)(xb_xcc_id() & 7u);
    for (int idx = queue8_next(heads, 96, cur, lds, rd); idx >= 0; ) {
        unsigned pre = 0u;
        const int qb = 31 - idx / 3, b = cur >> 1, h = (cur & 1) * 3 + idx % 3; const size_t tok0 = (size_t)b * SEQ;
        at::attn_unit<1>((LAS char*)(lds + RING_OFF), PROJ + (tok0 + qb * 128) * INP + C_DQ + h * 128, INP, PROJ + tok0 * INP + C_DK + h * 128, PROJ + tok0 * INP + C_DV + h * 128, INP,
                         nullptr, qb * 128, 2 * (qb + 1), MIX + (tok0 + qb * 128) * D + 768 + h * 128, D, lam, subg, 1.0f - lam_init, heads + 64 * cur, pre);
        idx = queue8_take(pre, heads, 96, cur, lds, rd);
    }
}
PHFN void ph_attn_cross(LAS unsigned char* lds, const bf16* QC, const bf16* KVL  , bf16* OC) {
    for (int u = (int)blockIdx.x; u < 256; u += (int)gridDim.x) {
        const int pm = (u & 7) * 8 + ((u >> 3) & 7), h = u >> 6, b = pm >> 4; const size_t tok0 = (size_t)pm * 256; unsigned nopre = 0u;
        const bf16* kv = KVL + (size_t)(b * MEMLEN) * (2 * CRW) + h * 128;
        at::attn_unit<2>((LAS char*)(lds + RING_OFF), QC + tok0 * CRW + h * 128, CRW, kv, kv + CRW, 2 * CRW, nullptr, 0, MEMLEN / 64, OC + tok0 * CRW + h * 128, CRW, 0.f, nullptr, 0.f, nullptr, nopre);
    }
}

#ifndef PROBE_DUP
#define PROBE_DUP 0
#endif
constexpr int N_STEPS = 2 + 8 * 2 + DEPTH * 6 + 1;
__global__ void __launch_bounds__(NTHR, 2) fwd(Params p) {
    extern __shared__ __attribute__((aligned(16))) unsigned char lds_raw[];
    LAS unsigned char* lds = (LAS unsigned char*)lds_raw;
    const int tid = threadIdx.x;
    unsigned* ctl = (unsigned*)(p.ws + WS_CTL);
    for (int u = tid; u < (LDS_BYTES - LDSCTL_OFF) / 4; u += NTHR) ((LAS unsigned*)(lds + LDSCTL_OFF))[u] = 0u;
    __syncthreads();
    XcdBarrier bar; bar.bar = ctl + CW_BAR; bar.x = 0; bar.st = nullptr;
    if (p.s_hi - p.s_lo > 1) bar = xcd_barrier_post(ctl + CW_BAR, (volatile LAS unsigned*)(lds + MISC_OFF) + 8);
    if (tid == 0) __hip_atomic_store(ctl + CW_GXCC + blockIdx.x, xb_xcc_id() + 1u, __ATOMIC_RELAXED, __HIP_MEMORY_SCOPE_AGENT);
    const bool grouped = gridDim.x == 256 && p.s_hi - p.s_lo > 1;
    int cur = 0;
#if PROBE_DUP & 512
#define PH_ENDG  if (cur + 1 < p.s_hi) { if (grouped) { group_barrier(ctl, (volatile LAS unsigned*)(lds + MISC_OFF) + 10); group_barrier(ctl, (volatile LAS unsigned*)(lds + MISC_OFF) + 10); group_barrier(ctl, (volatile LAS unsigned*)(lds + MISC_OFF) + 10); } else xcd_barrier(bar); } } ++cur;
#elif PROBE_DUP & 16384
#define PH_ENDG  if (cur + 1 < p.s_hi) { __syncthreads(); const unsigned long long t0_ = wall_clock64(); if (grouped) group_barrier(ctl, (volatile LAS unsigned*)(lds + MISC_OFF) + 10); else xcd_barrier(bar); if (tid == 0) ((LAS unsigned*)(lds + MISC_OFF))[14] += (unsigned)(wall_clock64() - t0_); } } ++cur;
#else
#define PH_ENDG  if (cur + 1 < p.s_hi) { if (grouped) group_barrier(ctl, (volatile LAS unsigned*)(lds + MISC_OFF) + 10); else xcd_barrier(bar); } } ++cur;
#endif
#define PH_ENDB  if (cur + 1 < p.s_hi) { if (grouped) batch_post(ctl, (blockIdx.x & 7u) >> 1); else xcd_barrier(bar); } } ++cur;
#define PH_BEGIN if (p.s_lo <= cur && cur < p.s_hi) {
#if PROBE_DUP & 512
#define PH_END   if (cur + 1 < p.s_hi) { xcd_barrier(bar); xcd_barrier(bar); } } ++cur;
#elif PROBE_DUP & 16384
    int accw = 12;
#define PH_END   if (cur + 1 < p.s_hi) { __syncthreads(); const unsigned long long t0_ = wall_clock64(); xcd_barrier(bar); if (tid == 0) ((LAS unsigned*)(lds + MISC_OFF))[accw] += (unsigned)(wall_clock64() - t0_); accw = 12; } } ++cur;
#else
#define PH_END   if (cur + 1 < p.s_hi) xcd_barrier(bar); } ++cur;
#endif
    bf16* const HB = (bf16*)(p.ws + WS_NB); unsigned long long* ssq = (unsigned long long*)(p.ws + WS_SSQ);     bf16* const ACT = (bf16*)(p.ws + WS_ACT); bf16* const PROJ = (bf16*)(p.ws + WS_PROJ); bf16* const MIX = (bf16*)(p.ws + WS_MIX);
    bf16* const QC = (bf16*)(p.ws + WS_QC); bf16* const OC = (bf16*)(p.ws + WS_OC); bf16* const KVB = (bf16*)(p.ws + WS_KV);
    float* const LOGF = (float*)(p.ws + WS_LOGF);

    PH_BEGIN ph_prologue(p, lds);
#if PROBE_DUP & 2
        ph_prologue(p, lds);
#endif
    PH_END
    PH_BEGIN ph_gemm_kv(lds, (const bf16*)(p.ws + WS_MEMN), (const bf16*)(p.ws + WS_W + LW_KV), KVB); PH_END
    for (int j = 0; j < 2 * DEPTH; ++j) {
        const int l = j >> 1; const bool second = (j & 1) != 0;
        const unsigned char* wl = p.ws + WS_W + (size_t)l * LW_SIZE;
        PH_BEGIN
#if PROBE_DUP & 8192
            for (int rep = 0; rep < 2; ++rep)
                ph_gemm_swiglu(lds, HB, (const bf16*)(wl + (second ? LW_GU2 : LW_GU1)), rep ? PROJ : ACT, ssq, rep);
#elif PROBE_DUP & 4096
            for (int rep = 0; rep < 2; ++rep) {
                ph_gemm_swiglu(lds, HB, (const bf16*)(wl + (second ? LW_GU2 : LW_GU1)), ACT, ssq); if (rep == 0) xcd_barrier(bar); }
#else
            ph_gemm_swiglu(lds, HB, (const bf16*)(wl + (second ? LW_GU2 : LW_GU1)), ACT, ssq);
#endif
#if PROBE_DUP & 4
            ph_gemm_swiglu(lds, HB, (const bf16*)(wl + (second ? LW_GU2 : LW_GU1)), ACT, ssq);
#endif
        PH_ENDG
        PH_BEGIN ph_gemm_resid(lds, ACT, (const bf16*)(wl + (second ? LW_D2 : LW_D1)), FF, HB, ssq + M, 0.5f);
#if PROBE_DUP & 64
            ph_gemm_resid(lds, ACT, (const bf16*)(wl + (second ? LW_D2 : LW_D1)), FF, HB, (unsigned long long*)(p.ws + WS_SSQ) + 17 * (size_t)M, 0.0f);
#endif
        PH_ENDG
        ssq += M;
        if (!second) {
            PH_BEGIN
                ph_ff(HB, ssq, (const bf16*)(p.ws + WS_WFF) + (size_t)l * NFH * D, p.in[I_FBIAS] + l * NFH, LOGF, lds);
                ph_gemm_bf16(lds, HB, (const bf16*)(wl + LW_IN), INP, PROJ, ssq, (const float*)(p.ws + WS_ROPE));
#if PROBE_DUP & 16384
                accw = 15;
#endif
#if PROBE_DUP & 32
                ph_gemm_bf16(lds, HB, (const bf16*)(wl + LW_IN), INP, PROJ, ssq, (const float*)(p.ws + WS_ROPE));
#endif
            PH_ENDB
            const Ready rd{ctl, 64u * (unsigned)(l + 1), (volatile LAS unsigned*)(lds + MISC_OFF) + 16, grouped};
            PH_BEGIN
                ph_attn_fox(lds, PROJ, LOGF, MIX, ctl + CW_QUEUE + 512 * (3 * l), rd);
                ph_attn_diff(lds, PROJ, MIX, ctl + CW_QUEUE + 512 * (3 * l + 1), p.in[I_LQ1] + l * 64, p.in[I_LK1] + l * 64, p.in[I_LQ2] + l * 64, p.in[I_LK2] + l * 64, p.in[I_SUBLN] + l * 128, l, rd);
                ph_conv(p, l, ctl + CW_QUEUE + 512 * (3 * l) + 32, lds, rd);
#if PROBE_DUP & 16384
                accw = 13;
#endif
#if PROBE_DUP & 1
                ph_attn_fox(lds, PROJ, LOGF, MIX, ctl + CW_QUEUE + 512 * (12 + 3 * l), rd);
                ph_attn_diff(lds, PROJ, MIX, ctl + CW_QUEUE + 512 * (12 + 3 * l + 1), p.in[I_LQ1] + l * 64, p.in[I_LK1] + l * 64, p.in[I_LQ2] + l * 64, p.in[I_LK2] + l * 64, p.in[I_SUBLN] + l * 128, l, rd);
#endif
            PH_END
            PH_BEGIN ph_gemm_resid(lds, MIX, (const bf16*)(wl + LW_OUT), D, HB, ssq + M, 1.0f);
#if PROBE_DUP & 128
                ph_gemm_resid(lds, MIX, (const bf16*)(wl + LW_OUT), D, HB, (unsigned long long*)(p.ws + WS_SSQ) + 17 * (size_t)M, 0.0f);
#endif
            PH_ENDG
            ssq += M;
            PH_BEGIN ph_gemm_bf16(lds, HB, (const bf16*)(wl + LW_Q), CRW, QC, ssq, nullptr); PH_ENDG
            PH_BEGIN ph_attn_cross(lds, QC, KVB + (size_t)l * MMEM * 2 * CRW, OC);
#if PROBE_DUP & 16
                ph_attn_cross(lds, QC, KVB + (size_t)l * MMEM * 2 * CRW, OC);
#endif
            PH_ENDG
            PH_BEGIN ph_gemm_resid(lds, OC, (const bf16*)(wl + LW_O), CRW, HB, ssq + M, 1.0f);
#if PROBE_DUP & 256
                ph_gemm_resid(lds, OC, (const bf16*)(wl + LW_O), CRW, HB, (unsigned long long*)(p.ws + WS_SSQ) + 17 * (size_t)M, 0.0f);
#endif
            PH_ENDG
            ssq += M;
        }
    }
    PH_BEGIN ph_norm_out(HB, p.out, p.in[I_FINN]); PH_END
#if PROBE_DUP & 16384
    {   xcd_barrier(bar); unsigned* st = ctl + 8960;
        if (tid == 0) { const unsigned g = ((LAS unsigned*)(lds + MISC_OFF))[12], a = ((LAS unsigned*)(lds + MISC_OFF))[13];
            atomicMax(st + 0, g); atomicMax(st + 1, ~g); atomicAdd(st + 2, g); atomicMax(st + 3, a); atomicMax(st + 4, ~a); atomicAdd(st + 5, a);
            const unsigned gg = ((LAS unsigned*)(lds + MISC_OFF))[14]; atomicAdd(st + 6, gg); atomicMax(st + 7, ~gg);
            atomicAdd(st + 16 + (xb_xcc_id() & 7u), ((LAS unsigned*)(lds + MISC_OFF))[15]); }
        xcd_barrier(bar);
        if (blockIdx.x == 0 && tid == 0) { const int sel = (PROBE_DUP >> 16) & 7;
            unsigned xmin = 0xffffffffu, xmax = 0u; for (int j = 0; j < 8; ++j) { const unsigned s = xb_ld(st + 16 + j) / 32u; xmin = s < xmin ? s : xmin; xmax = s > xmax ? s : xmax; }
            const int sel8 = (PROBE_DUP >> 19) & 3;
            const unsigned v = sel8 == 1 ? xmin : sel8 == 2 ? xmax : sel == 0 ? xb_ld(st + 0) : sel == 1 ? ~xb_ld(st + 1) : sel == 2 ? xb_ld(st + 2) / gridDim.x : sel == 3 ? xb_ld(st + 3) : sel == 4 ? ~xb_ld(st + 4) : sel == 5 ? xb_ld(st + 5) / gridDim.x : sel == 6 ? xb_ld(st + 6) / gridDim.x : ~xb_ld(st + 7);
            const unsigned long long t0 = wall_clock64(); while (wall_clock64() - t0 < 4ull * v) __builtin_amdgcn_s_sleep(8); } }
#endif
#undef PH_BEGIN
#undef PH_END
#undef PH_ENDG
#undef PH_ENDB
}

extern "C" void kernel_launch(void* const* d_in, const int* in_sizes, int n_in, void* d_out, int out_size, void* d_ws, size_t ws_size, hipStream_t stream) {
    static int grid = 0;
    if (grid == 0) {
        if (n_in != 28 || in_sizes[0] != M * D || out_size != M * D || ws_size < WS_END) { fprintf(stderr, "kernel_launch: unexpected problem: n_in %d in0 %d out %d ws %zu (need %zu)\n", n_in, n_in > 0 ? in_sizes[0] : -1, out_size, ws_size, (size_t)WS_END); grid = -1; return; }
        int dev = 0, cus = 0, per_cu = 0;
        if (hipGetDevice(&dev) != hipSuccess || hipDeviceGetAttribute(&cus, hipDeviceAttributeMultiprocessorCount, dev) != hipSuccess) { grid = -1; return; }
        if (hipFuncSetAttribute((const void*)fwd, hipFuncAttributeMaxDynamicSharedMemorySize, LDS_BYTES) != hipSuccess) { fprintf(stderr, "kernel_launch: hipFuncSetAttribute failed\n"); grid = -1; return; }
        if (hipOccupancyMaxActiveBlocksPerMultiprocessor(&per_cu, (const void*)fwd, NTHR, LDS_BYTES) != hipSuccess || per_cu < 1) fprintf(stderr, "kernel_launch: occupancy query reports %d\n", per_cu);
        (void)hipGetLastError();
        grid = cus;
    }
    if (grid < 0) return;
    (void)hipMemsetAsync((char*)d_ws + WS_CTL, 0, CTL_ZERO_BYTES, stream);
    Params a{};
    for (int i = 0; i < 28; ++i) a.in[i] = (const float*)d_in[i];
    a.out = (float*)d_out; a.ws = (unsigned char*)d_ws;
#if MK_ONE_LAUNCH
    a.s_lo = 0; a.s_hi = N_STEPS;
    hipLaunchKernelGGL(fwd, dim3(grid), dim3(NTHR), LDS_BYTES, stream, a);
#else
    for (int s = 0; s < N_STEPS; ++s) { a.s_lo = s; a.s_hi = s + 1; hipLaunchKernelGGL(fwd, dim3(grid), dim3(NTHR), LDS_BYTES, stream, a); }
#endif
}
```
